# Optimizing an MI355X kernel written in HIP

```python
import jax, jax.numpy as jnp
from jax import lax
import numpy as np

D_MODEL = 1024
BATCH = 16
SEQ = 4096
DEPTH = 1
DEC_BATCH = 8
DEC_SEQ = 4096
PAST_LEN = 128

HEAD_DIM = 64
N_MIX_HEADS = D_MODEL // HEAD_DIM
A_Q_HEADS = N_MIX_HEADS // 2
A_KV_HEADS = 2
A_GROUP = A_Q_HEADS // A_KV_HEADS
A_HALF_WINDOW = 128
A_BLOCK = 128
B_HEADS = N_MIX_HEADS - A_Q_HEADS
B_PAIRS = ((128, 1), (512, 4), (2048, 16))
B_BLOCK = 64
A_WIDTH = A_Q_HEADS * HEAD_DIM
A_KV_WIDTH = A_KV_HEADS * HEAD_DIM
B_WIDTH = B_HEADS * HEAD_DIM
IN_WIDTH = A_WIDTH + 2 * A_KV_WIDTH + 3 * B_WIDTH
MIX_WIDTH = A_WIDTH + B_WIDTH
D_FF = ((8 * D_MODEL // 3 + 255) // 256) * 256
ROPE_THETA = 500000.0
ROPE_DIM = HEAD_DIM // 4
NORM_EPS = 1e-6
NEG_INF = -1e30

kernel_name = 'hymba_swa_sink_longnet_macaron_encoder'


def rmsnorm(x, g):
    xf = x.astype(jnp.float32)
    y = xf * lax.rsqrt(jnp.mean(xf * xf, axis=-1, keepdims=True) + NORM_EPS) * g.astype(jnp.float32)
    return y.astype(x.dtype)


def swiglu(x, w_gate, w_up, w_down):
    return (jax.nn.silu(x @ w_gate) * (x @ w_up)) @ w_down


def partial_rotary(x, pos):
    half = ROPE_DIM // 2
    inv = jnp.power(jnp.float32(ROPE_THETA), -jnp.arange(half, dtype=jnp.float32) * (2.0 / ROPE_DIM))
    ang = pos.astype(jnp.float32)[:, None] * inv[None, :]
    cos = jnp.cos(ang)[None, :, None, :]
    sin = jnp.sin(ang)[None, :, None, :]
    xf = x.astype(jnp.float32)
    x1, x2, rest = xf[..., :half], xf[..., half:ROPE_DIM], xf[..., ROPE_DIM:]
    out = jnp.concatenate([x1 * cos - x2 * sin, x2 * cos + x1 * sin, rest], axis=-1)
    return out.astype(x.dtype)


def banded_attention(q, k, v, half_window, block, sink=None):
    n, L, hk, g, dh = q.shape
    nb = -(-L // block)
    Lp = nb * block
    q = jnp.pad(q, ((0, 0), (0, Lp - L), (0, 0), (0, 0), (0, 0)))
    kv_pad = ((0, 0), (block, block + Lp - L), (0, 0), (0, 0))
    k = jnp.pad(k, kv_pad)
    v = jnp.pad(v, kv_pad)
    qb = q.reshape(n, nb, block, hk, g, dh)

    def windows(t):
        return jnp.concatenate(
            [t[:, i * block:i * block + Lp].reshape(n, nb, block, hk, dh) for i in range(3)], axis=2)

    kb, vb = windows(k), windows(v)
    qpos = jnp.arange(nb)[:, None] * block + jnp.arange(block)[None, :]
    kpos = (jnp.arange(nb)[:, None] - 1) * block + jnp.arange(3 * block)[None, :]
    mask = (jnp.abs(kpos[:, None, :] - qpos[:, :, None]) <= half_window) & \
        ((kpos >= 0) & (kpos < L))[:, None, :]
    s = jnp.einsum('nbqhgd,nbkhd->nbhgqk', qb, kb, preferred_element_type=jnp.float32) * (dh ** -0.5)
    s = jnp.where(mask[None, :, None, None], s, NEG_INF)
    m = jnp.max(s, axis=-1)
    if sink is not None:
        sink_f = sink.astype(jnp.float32)[:, :, None]
        m = jnp.maximum(m, sink_f)
    e = jnp.exp(s - m[..., None])
    denom = jnp.sum(e, axis=-1)
    if sink is not None:
        denom = denom + jnp.exp(sink_f - m)
    p = (e / denom[..., None]).astype(v.dtype)
    o = jnp.einsum('nbhgqk,nbkhd->nbqhgd', p, vb).reshape(n, Lp, hk, g, dh)[:, :L]
    lse = (m + jnp.log(denom)).transpose(0, 1, 4, 2, 3).reshape(n, Lp, hk, g)[:, :L]
    return o, lse


def dilated_attention(q, k, v):
    n, S, h, dh = q.shape
    outs, lses = [], []
    for window, d in B_PAIRS:
        hw = window // (2 * d)
        L = S // d

        def to_sub(t):
            return t.reshape(n, L, d, h, dh).transpose(0, 2, 1, 3, 4).reshape(n * d, L, h, dh)

        o, lse = banded_attention(to_sub(q)[:, :, :, None], to_sub(k), to_sub(v), hw, B_BLOCK)
        outs.append(o[:, :, :, 0].reshape(n, d, L, h, dh).transpose(0, 2, 1, 3, 4).reshape(n, S, h, dh))
        lses.append(lse[..., 0].reshape(n, d, L, h).transpose(0, 2, 1, 3).reshape(n, S, h))
    alpha = jax.nn.softmax(jnp.stack(lses, axis=0), axis=0)
    return jnp.einsum('gnsh,gnshd->nshd', alpha.astype(q.dtype), jnp.stack(outs, axis=0))


def token_mixer(h, w_in, a_sink, a_out_norm, b_out_norm, w_out):
    n, S, _ = h.shape
    pos = jnp.arange(S)
    proj = h @ w_in
    cuts = [A_WIDTH, A_WIDTH + A_KV_WIDTH, A_WIDTH + 2 * A_KV_WIDTH,
            A_WIDTH + 2 * A_KV_WIDTH + B_WIDTH, A_WIDTH + 2 * A_KV_WIDTH + 2 * B_WIDTH]
    aq, ak, av, bq, bk, bv = jnp.split(proj, cuts, axis=-1)
    aq = partial_rotary(aq.reshape(n, S, A_Q_HEADS, HEAD_DIM), pos).reshape(n, S, A_KV_HEADS, A_GROUP, HEAD_DIM)
    ak = partial_rotary(ak.reshape(n, S, A_KV_HEADS, HEAD_DIM), pos)
    av = av.reshape(n, S, A_KV_HEADS, HEAD_DIM)
    oa, _ = banded_attention(aq, ak, av, A_HALF_WINDOW, A_BLOCK, sink=a_sink)
    oa = oa.reshape(n, S, A_WIDTH)
    bq = partial_rotary(bq.reshape(n, S, B_HEADS, HEAD_DIM), pos)
    bk = partial_rotary(bk.reshape(n, S, B_HEADS, HEAD_DIM), pos)
    bv = bv.reshape(n, S, B_HEADS, HEAD_DIM)
    ob = dilated_attention(bq, bk, bv).reshape(n, S, B_WIDTH)
    merged = jnp.concatenate([rmsnorm(oa, a_out_norm), rmsnorm(ob, b_out_norm)], axis=-1)
    return merged @ w_out


def trunk(x, ffn1_norm, ffn1_w_gate, ffn1_w_up, ffn1_w_down, mix_norm, w_in, a_sink,
          a_out_norm, b_out_norm, w_out, ffn2_norm, ffn2_w_gate, ffn2_w_up, ffn2_w_down, final_norm):
    for l in range(DEPTH):
        x = x + 0.5 * swiglu(rmsnorm(x, ffn1_norm[l]), ffn1_w_gate[l], ffn1_w_up[l], ffn1_w_down[l])
        x = x + token_mixer(rmsnorm(x, mix_norm[l]), w_in[l], a_sink[l], a_out_norm[l], b_out_norm[l], w_out[l])
        x = x + 0.5 * swiglu(rmsnorm(x, ffn2_norm[l]), ffn2_w_gate[l], ffn2_w_up[l], ffn2_w_down[l])
    return rmsnorm(x, final_norm)


def setup_inputs(seed: int = 0) -> dict:
    key = jax.random.key(seed)
    ks = jax.random.split(key, 20)
    f32 = jnp.float32

    def w(k, shape, fan_in):
        return jax.random.normal(k, shape, f32) * (fan_in ** -0.5)

    def gain(k, shape):
        return 1.0 + 0.02 * jax.random.normal(k, shape, f32)

    return {
        'x_prompt': jax.random.normal(ks[0], (BATCH, SEQ, D_MODEL), f32),
        'x_sample': jax.random.normal(ks[1], (DEC_BATCH, DEC_SEQ, D_MODEL), f32),
        'ffn1_norm': gain(ks[2], (DEPTH, D_MODEL)),
        'ffn1_w_gate': w(ks[3], (DEPTH, D_MODEL, D_FF), D_MODEL),
        'ffn1_w_up': w(ks[4], (DEPTH, D_MODEL, D_FF), D_MODEL),
        'ffn1_w_down': w(ks[5], (DEPTH, D_FF, D_MODEL), D_FF),
        'mix_norm': gain(ks[6], (DEPTH, D_MODEL)),
        'w_in': w(ks[7], (DEPTH, D_MODEL, IN_WIDTH), D_MODEL),
        'a_sink': jax.random.normal(ks[8], (DEPTH, A_KV_HEADS, A_GROUP), f32),
        'a_out_norm': gain(ks[9], (DEPTH, A_WIDTH)),
        'b_out_norm': gain(ks[10], (DEPTH, B_WIDTH)),
        'w_out': w(ks[11], (DEPTH, MIX_WIDTH, D_MODEL), MIX_WIDTH),
        'ffn2_norm': gain(ks[12], (DEPTH, D_MODEL)),
        'ffn2_w_gate': w(ks[13], (DEPTH, D_MODEL, D_FF), D_MODEL),
        'ffn2_w_up': w(ks[14], (DEPTH, D_MODEL, D_FF), D_MODEL),
        'ffn2_w_down': w(ks[15], (DEPTH, D_FF, D_MODEL), D_FF),
        'final_norm': gain(ks[16], (D_MODEL,)),
    }


def reference(x_prompt, x_sample, ffn1_norm, ffn1_w_gate, ffn1_w_up, ffn1_w_down, mix_norm, w_in,
              a_sink, a_out_norm, b_out_norm, w_out, ffn2_norm, ffn2_w_gate, ffn2_w_up, ffn2_w_down,
              final_norm):
    y_prompt = trunk(x_prompt, ffn1_norm, ffn1_w_gate, ffn1_w_up, ffn1_w_down, mix_norm, w_in, a_sink,
                     a_out_norm, b_out_norm, w_out, ffn2_norm, ffn2_w_gate, ffn2_w_up, ffn2_w_down, final_norm)
    y_sample = trunk(x_sample, ffn1_norm, ffn1_w_gate, ffn1_w_up, ffn1_w_down, mix_norm, w_in, a_sink,
                     a_out_norm, b_out_norm, w_out, ffn2_norm, ffn2_w_gate, ffn2_w_up, ffn2_w_down, final_norm)
    return (y_prompt, y_sample)
```

```cpp
#include <hip/hip_runtime.h>
#include <hip/hip_cooperative_groups.h>
#include <cstdio>
#include <cstdint>
namespace cg = cooperative_groups;
namespace pg8 {
#define PG8_LAS __attribute__((address_space(3)))
typedef unsigned short bf16_t;
typedef short bf16x8 __attribute__((ext_vector_type(8)));
typedef float f32x4 __attribute__((ext_vector_type(4)));
typedef unsigned u32x4 __attribute__((ext_vector_type(4)));
constexpr int BM = 256, BK = 64, HALF = 128, HTB = HALF * BK * 2  , STAGE_BYTES = 8 * HTB, NXCD = 8, WGM = 8;

__host__ __device__ __forceinline__ int lds_byte(int r, int c) { const int st = (r >> 4) * 2 + (c >> 5), rr = r & 15, cc = c & 31, ob = rr * 64 + cc * 2; return st * 1024 + (ob ^ (((ob >> 9) & 1) << 5)); }
__host__ __device__ __forceinline__ void stage_rc(int b, int& R, int& C) { const int st = b / 1024, sb = b % 1024, swz = sb ^ (((sb >> 9) & 1) << 5); R = (st >> 1) * 16 + swz / 64; C = (st & 1) * 32 + (swz % 64) / 2; }
__host__ __device__ __forceinline__ int perm32(int rho) { const int n = rho >> 4, i = rho & 15; return 8 * (i >> 2) + 4 * n + (i & 3); }

struct Unit { int pm, pn; };
struct Gemm { const bf16_t* A; const bf16_t* Bt; int M, N, K; };

struct StaticOrder {
    int nM, nN, nwg, G, c;
    __host__ __device__ void init(int M, int N, int G_, int c_) { nM = M / BM; nN = N / BM; nwg = nM * nN; G = G_; c = c_; }
    __host__ __device__ bool next(int i, Unit& u) const {
        const long L = (long)i * G + c; if (L >= nwg) return false;
        int wgid = (int)L; { const int q = nwg / NXCD, r = nwg % NXCD, xcd = wgid % NXCD, off = wgid / NXCD; wgid = (xcd < r ? xcd * (q + 1) : r * (q + 1) + (xcd - r) * q) + off; }
        const int nig = WGM * nN, gid = wgid / nig, fm = gid * WGM, gsz = (nM - fm) < WGM ? (nM - fm) : WGM;
        u.pm = fm + ((wgid % nig) % gsz); u.pn = (wgid % nig) / gsz; return true;
    }
    __device__ __forceinline__ void a_ready(const Unit&) const {}
    __device__ __forceinline__ void done(const Unit&) const {}
};
__device__ __forceinline__ unsigned cvt_pk_bf16(float lo, float hi) { unsigned r; asm volatile("v_cvt_pk_bf16_f32 %0, %1, %2" : "=v"(r) : "v"(lo), "v"(hi)); return r; }

__device__ __forceinline__ float silu_f(float x) { return x * __builtin_amdgcn_rcpf(1.0f + __builtin_amdgcn_exp2f(-1.4426950408889634f * x)); }
__device__ __forceinline__ float rstd_of(float ss) { return __builtin_amdgcn_rsqf(ss * (1.0f / 1024.0f) + 1e-6f); }

struct EpiGateUp {
    static constexpr bool PERM = true, AFTER_DRAIN = false;
    bf16_t* H; const float* ss;
    __device__ __forceinline__ void operator()(const f32x4 (&acc)[2][2][4][2], const Unit& u, int wr, int wc, int fr, int fq) const {
        const int row0 = u.pm * BM + wr * 64 + fr, hcol = u.pn * 128 + wc * 32 + fq * 8;
#pragma unroll
        for (int ai = 0; ai < 2; ++ai)
#pragma unroll
            for (int m = 0; m < 4; ++m) {
                const int row = row0 + ai * HALF + m * 16; const float rs = rstd_of(ss[row]);
                const f32x4 g0 = acc[ai][0][m][0] * rs, g1 = acc[ai][1][m][0] * rs, u0 = acc[ai][0][m][1] * rs, u1 = acc[ai][1][m][1] * rs;
                u32x4 w;
                w.x = cvt_pk_bf16(silu_f(g0[0]) * u0[0], silu_f(g0[1]) * u0[1]); w.y = cvt_pk_bf16(silu_f(g0[2]) * u0[2], silu_f(g0[3]) * u0[3]);
                w.z = cvt_pk_bf16(silu_f(g1[0]) * u1[0], silu_f(g1[1]) * u1[1]); w.w = cvt_pk_bf16(silu_f(g1[2]) * u1[2], silu_f(g1[3]) * u1[3]);
                *(u32x4*)(H + (size_t)row * 2816 + hcol) = w;
                asm volatile("" ::: "memory");
            }
    }
};

struct EpiResid {
    static constexpr bool PERM = true, AFTER_DRAIN = false;
    const float* res_lo; const float* res_hi; int split;
    float* out; bf16_t* xb; float* ssout; float alpha;
    __device__ __forceinline__ void operator()(const f32x4 (&acc)[2][2][4][2], const Unit& u, int wr, int wc, int fr, int fq) const {
        const int row0 = u.pm * BM + wr * 64 + fr, col0 = u.pn * BM + wc * 32 + fq * 8;
        const float* rbase = (u.pm * BM < split) ? res_lo : res_hi - (size_t)split * 1024;
#pragma unroll
        for (int ai = 0; ai < 2; ++ai)
#pragma unroll
            for (int m = 0; m < 4; ++m) {
                const int row = row0 + ai * HALF + m * 16; float s = 0.f;
#pragma unroll
                for (int bj = 0; bj < 2; ++bj) {
                    const size_t off = (size_t)row * 1024 + col0 + bj * HALF;
                    const f32x4 r0 = *(const f32x4*)(rbase + off), r1 = *(const f32x4*)(rbase + off + 4);
                    const f32x4 v0 = r0 + alpha * acc[ai][bj][m][0], v1 = r1 + alpha * acc[ai][bj][m][1];
                    *(f32x4*)(out + off) = v0; *(f32x4*)(out + off + 4) = v1;
                    if (xb) { u32x4 w; w.x = cvt_pk_bf16(v0[0], v0[1]); w.y = cvt_pk_bf16(v0[2], v0[3]); w.z = cvt_pk_bf16(v1[0], v1[1]); w.w = cvt_pk_bf16(v1[2], v1[3]); *(u32x4*)(xb + off) = w; }
                    s += (v0[0] * v0[0] + v0[1] * v0[1]) + (v0[2] * v0[2] + v0[3] * v0[3]) + (v1[0] * v1[0] + v1[1] * v1[1]) + (v1[2] * v1[2] + v1[3] * v1[3]);
                }
                s += __shfl_xor(s, 16); s += __shfl_xor(s, 32);
                if (fq == 0) atomicAdd(ssout + row, s);
                asm volatile("" ::: "memory");
            }
    }
};

struct EpiQkv {
    static constexpr bool PERM = true, AFTER_DRAIN = false;
    bf16_t* P; const float* ss; const float* rope;
    __device__ __forceinline__ void operator()(const f32x4 (&acc)[2][2][4][2], const Unit& u, int wr, int wc, int fr, int fq) const {
        const int row0 = u.pm * BM + wr * 64 + fr, col0 = u.pn * BM + wc * 32 + fq * 8; const int pn = u.pn;
        const bool isq = (pn <= 1) || (pn == 3) || (pn == 4);
        const float qs = isq ? 0.125f * 1.4426950408889634f : 1.0f;
#pragma unroll
        for (int ai = 0; ai < 2; ++ai)
#pragma unroll
            for (int m = 0; m < 4; ++m) {
                const int row = row0 + ai * HALF + m * 16; const float rs = rstd_of(ss[row]) * qs;
                const float* rp = rope + (size_t)(row & 4095) * 16;
#pragma unroll
                for (int bj = 0; bj < 2; ++bj) {
                    f32x4 v0 = acc[ai][bj][m][0] * rs, v1 = acc[ai][bj][m][1] * rs;
                    const bool rot = ((pn <= 6) && !(pn == 2 && bj == 1)) && ((wc & 1) == 0);
                    if (rot) {
                        const float sg = fq == 0 ? -1.0f : 1.0f; const bool act = fq < 2;
                        { f32x4 o0;
#pragma unroll
                          for (int j = 0; j < 4; ++j) o0[j] = __shfl_xor(v0[j], 16);
                          if (act) { const f32x4 c0 = *(const f32x4*)(rp), s0 = *(const f32x4*)(rp + 8); v0 = v0 * c0 + sg * (o0 * s0); } }
                        { f32x4 o1;
#pragma unroll
                          for (int j = 0; j < 4; ++j) o1[j] = __shfl_xor(v1[j], 16);
                          if (act) { const f32x4 c1 = *(const f32x4*)(rp + 4), s1 = *(const f32x4*)(rp + 12); v1 = v1 * c1 + sg * (o1 * s1); } }
                    }
                    u32x4 w; w.x = cvt_pk_bf16(v0[0], v0[1]); w.y = cvt_pk_bf16(v0[2], v0[3]); w.z = cvt_pk_bf16(v1[0], v1[1]); w.w = cvt_pk_bf16(v1[2], v1[3]);
                    *(u32x4*)(P + (size_t)row * 2304 + col0 + bj * HALF) = w;
                    asm volatile("" ::: "memory");
                }
            }
    }
};
template <class Epi, class Sched, bool ALIGN_EPI = false, bool SP2 = false>
__device__ __forceinline__ void gemm_phase(PG8_LAS unsigned char* lds, const Gemm g, const Sched& S, const Epi& E, const int tid) {
    const int  wid = __builtin_amdgcn_readfirstlane(tid >> 6), lane = tid & 63, wr = wid >> 2, wc = wid & 3, fr = lane & 15, fq = lane >> 4;
    const int K = g.K, nt = K / BK;
    unsigned voffA[2], voffB[2];
#pragma unroll
    for (int i = 0; i < 2; ++i) { int R, C; stage_rc(tid * 16 + i * 8192, R, C); const int Rb = Epi::PERM ? ((R & ~31) + perm32(R & 31)) : R;
        voffA[i] = (unsigned)(R * K + C) * 2u; voffB[i] = (unsigned)(Rb * K + C) * 2u; }
    const size_t kstep = (size_t)(BK * 2);
    const size_t hstep = (size_t)HALF * K * 2;
    const size_t tstep = 2 * hstep;
    const unsigned ldsw = (unsigned)wid * 1024u;
    const int aoff = lds_byte(wr * 64 + fr, fq * 8), boff = lds_byte(wc * 32 + fr, fq * 8);
#define PG8_SA(b, h) (((b) * 2 + (h)) * HTB)
#define PG8_SB(b, h) ((4 + (b) * 2 + (h)) * HTB)
#define PG8_STAGE(bufoff, gbase, voff) do { _Pragma("unroll") for (int _i = 0; _i < 2; ++_i) \
        __builtin_amdgcn_global_load_lds((const unsigned*)((const char*)(gbase) + (voff)[_i]), (PG8_LAS unsigned*)(lds + (bufoff) + ldsw + _i * 8192), 16, 0, 0); } while (0)
#define PG8_LDA(dst, b, h) do { _Pragma("unroll") for (int m = 0; m < 4; ++m) _Pragma("unroll") for (int k = 0; k < 2; ++k) dst[m][k] = *(const PG8_LAS bf16x8*)(lds + PG8_SA(b, h) + aoff + m * 2048 + k * 1024); } while (0)
#define PG8_LDB(dst, b, h) do { _Pragma("unroll") for (int n = 0; n < 2; ++n) _Pragma("unroll") for (int k = 0; k < 2; ++k) dst[n][k] = *(const PG8_LAS bf16x8*)(lds + PG8_SB(b, h) + boff + n * 2048 + k * 1024); } while (0)
#define PG8_MMA(ai, bj, At, Bt) do { __builtin_amdgcn_s_setprio(1); _Pragma("unroll") for (int m = 0; m < 4; ++m) _Pragma("unroll") for (int n = 0; n < 2; ++n) _Pragma("unroll") for (int k = 0; k < 2; ++k) \
        acc[ai][bj][m][n] = __builtin_amdgcn_mfma_f32_16x16x32_bf16(Bt[n][k], At[m][k], acc[ai][bj][m][n], 0, 0, 0); __builtin_amdgcn_s_setprio(0); } while (0)
#define PG8_WAIT_V(n) asm volatile("s_waitcnt vmcnt(" #n ")" ::: "memory")
#define PG8_WAIT_L(n) asm volatile("s_waitcnt lgkmcnt(" #n ")" ::: "memory")
#define PG8_BAR __builtin_amdgcn_s_barrier()
#define PG8_SCHED __builtin_amdgcn_sched_barrier(0)
    Unit cur, nxt; int ui = 0;
    if (!S.next(0, cur)) return;
    f32x4 acc[2][2][4][2];
#pragma unroll
    for (int a = 0; a < 2; ++a)
#pragma unroll
        for (int b = 0; b < 2; ++b)
#pragma unroll
            for (int m = 0; m < 4; ++m)
#pragma unroll
                for (int n = 0; n < 2; ++n) acc[a][b][m][n] = (f32x4){0.f, 0.f, 0.f, 0.f};
    bf16x8 At[4][2], B0[2][2], B1[2][2];
    const char* cA = (const char*)g.A + (size_t)cur.pm * tstep; const char* cB = (const char*)g.Bt + (size_t)cur.pn * tstep;
    S.a_ready(cur);
    if constexpr (SP2) {
        PG8_STAGE(PG8_SB(0, 0), cB, voffB); PG8_STAGE(PG8_SB(0, 1), cB + hstep, voffB); PG8_STAGE(PG8_SA(0, 0), cA, voffA); PG8_STAGE(PG8_SA(0, 1), cA + hstep, voffA);
        if (wr == 1) PG8_BAR;
        PG8_WAIT_V(2); PG8_BAR;
        PG8_STAGE(PG8_SB(1, 0), cB + kstep, voffB); PG8_STAGE(PG8_SA(1, 0), cA + kstep, voffA); PG8_STAGE(PG8_SB(1, 1), cB + hstep + kstep, voffB);
        PG8_WAIT_V(6); PG8_BAR;
    } else {
        PG8_STAGE(PG8_SB(0, 0), cB, voffB); PG8_STAGE(PG8_SA(0, 0), cA, voffA); PG8_STAGE(PG8_SB(0, 1), cB + hstep, voffB); PG8_STAGE(PG8_SA(0, 1), cA + hstep, voffA);
        if (wr == 1) PG8_BAR;
        PG8_WAIT_V(4); PG8_BAR;
        PG8_STAGE(PG8_SB(1, 0), cB + kstep, voffB); PG8_STAGE(PG8_SA(1, 0), cA + kstep, voffA); PG8_STAGE(PG8_SB(1, 1), cB + hstep + kstep, voffB);
        PG8_WAIT_V(6); PG8_BAR;
    }
    for (;;) {
        const bool has_next = S.next(ui + 1, nxt);
        const char* nA = has_next ? (const char*)g.A + (size_t)nxt.pm * tstep : cA; const char* nB = has_next ? (const char*)g.Bt + (size_t)nxt.pn * tstep : cB;
        for (int t = 0; t < nt; t += 2) {
            const bool last = (t == nt - 2);
            const char* a1 = cA + (size_t)(t + 1) * kstep;
            const char* a2 = last ? nA : cA + (size_t)(t + 2) * kstep; const char* b2 = last ? nB : cB + (size_t)(t + 2) * kstep;
            const char* a3 = a2 + kstep; const char* b3 = b2 + kstep;
            if (last && has_next) S.a_ready(nxt);
            if constexpr (SP2) {
            PG8_LDB(B0, 0, 0); PG8_LDB(B1, 0, 1); PG8_SCHED; PG8_LDA(At, 0, 0); PG8_STAGE(PG8_SA(1, 1), a1 + hstep, voffA);
            PG8_WAIT_V(8); PG8_WAIT_L(0); PG8_BAR; PG8_MMA(0, 0, At, B0); PG8_MMA(0, 1, At, B1); PG8_BAR; PG8_SCHED;
            PG8_LDA(At, 0, 1); PG8_STAGE(PG8_SB(0, 0), b2, voffB); PG8_STAGE(PG8_SB(0, 1), b2 + hstep, voffB); PG8_STAGE(PG8_SA(0, 0), a2, voffA);
            PG8_WAIT_V(8); PG8_WAIT_L(0); PG8_BAR; PG8_MMA(1, 0, At, B0); PG8_MMA(1, 1, At, B1); PG8_BAR; PG8_SCHED;
            PG8_LDB(B0, 1, 0); PG8_LDB(B1, 1, 1); PG8_SCHED; PG8_LDA(At, 1, 0); PG8_STAGE(PG8_SA(0, 1), a2 + hstep, voffA);
            PG8_WAIT_V(8); PG8_WAIT_L(0); PG8_BAR; PG8_MMA(0, 0, At, B0); PG8_MMA(0, 1, At, B1); PG8_BAR; PG8_SCHED;
            PG8_LDA(At, 1, 1); PG8_STAGE(PG8_SB(1, 0), b3, voffB); PG8_STAGE(PG8_SB(1, 1), b3 + hstep, voffB); PG8_STAGE(PG8_SA(1, 0), a3, voffA);
            PG8_WAIT_V(8); PG8_WAIT_L(0); PG8_BAR; PG8_MMA(1, 0, At, B0); PG8_MMA(1, 1, At, B1); PG8_BAR; PG8_SCHED;
            } else {
            PG8_LDB(B0, 0, 0); PG8_SCHED; PG8_LDA(At, 0, 0); PG8_STAGE(PG8_SA(1, 1), a1 + hstep, voffA);
            PG8_WAIT_L(8); PG8_BAR; PG8_WAIT_L(0); PG8_MMA(0, 0, At, B0); PG8_BAR; PG8_SCHED;
            PG8_LDB(B1, 0, 1); PG8_STAGE(PG8_SB(0, 0), b2, voffB);
            PG8_BAR; PG8_WAIT_L(0); PG8_MMA(0, 1, At, B1); PG8_BAR;
            PG8_LDA(At, 0, 1); PG8_STAGE(PG8_SA(0, 0), a2, voffA);
            PG8_BAR; PG8_WAIT_L(0); PG8_MMA(1, 0, At, B0); PG8_BAR; PG8_SCHED;
            PG8_STAGE(PG8_SB(0, 1), b2 + hstep, voffB);
            PG8_WAIT_V(6); PG8_BAR; PG8_MMA(1, 1, At, B1); PG8_BAR;
            PG8_LDB(B0, 1, 0); PG8_SCHED; PG8_LDA(At, 1, 0); PG8_STAGE(PG8_SA(0, 1), a2 + hstep, voffA);
            PG8_WAIT_L(8); PG8_BAR; PG8_WAIT_L(0); PG8_MMA(0, 0, At, B0); PG8_BAR; PG8_SCHED;
            PG8_LDB(B1, 1, 1); PG8_STAGE(PG8_SB(1, 0), b3, voffB);
            PG8_BAR; PG8_WAIT_L(0); PG8_MMA(0, 1, At, B1); PG8_BAR;
            PG8_LDA(At, 1, 1); PG8_STAGE(PG8_SA(1, 0), a3, voffA);
            PG8_BAR; PG8_WAIT_L(0); PG8_MMA(1, 0, At, B0); PG8_BAR; PG8_SCHED;
            PG8_STAGE(PG8_SB(1, 1), b3 + hstep, voffB);
            PG8_WAIT_V(6); PG8_BAR; PG8_MMA(1, 1, At, B1); PG8_BAR;
            }
        }
        if constexpr (ALIGN_EPI) { if (wr == 0) PG8_BAR; }
        if constexpr (!Epi::AFTER_DRAIN) { E(acc, cur, wr, wc, fr, fq); S.done(cur); }
        if (!has_next) break;
#pragma unroll
        for (int a = 0; a < 2; ++a)
#pragma unroll
            for (int b = 0; b < 2; ++b)
#pragma unroll
                for (int m = 0; m < 4; ++m)
#pragma unroll
                    for (int n = 0; n < 2; ++n) acc[a][b][m][n] = (f32x4){0.f, 0.f, 0.f, 0.f};
        cur = nxt; cA = nA; cB = nB; ++ui;
        if constexpr (ALIGN_EPI) { if (wr == 1) PG8_BAR; }
    }
    PG8_WAIT_V(0);
    if constexpr (!ALIGN_EPI) { if (wr == 0) PG8_BAR; }
    PG8_BAR;
    if constexpr (Epi::AFTER_DRAIN) { E.fused(acc, cur, wr, wc, fr, fq, lds, wid, lane); S.done(cur); }
#undef PG8_SA
#undef PG8_SB
#undef PG8_STAGE
#undef PG8_LDA
#undef PG8_LDB
#undef PG8_MMA
#undef PG8_WAIT_V
#undef PG8_WAIT_L
#undef PG8_BAR
#undef PG8_SCHED
}
}

namespace mk {
using pg8::bf16_t;
typedef short bf16x8 __attribute__((ext_vector_type(8)));
typedef short s16x4 __attribute__((ext_vector_type(4)));
typedef float f32x16 __attribute__((ext_vector_type(16)));
typedef float f32x4 __attribute__((ext_vector_type(4)));
typedef unsigned u32x4 __attribute__((ext_vector_type(4)));
#define MK_LAS __attribute__((address_space(3)))
constexpr int T = 98304, TP = 65536, D = 1024, FF = 2816, INW = 2304, SEQ = 4096;
constexpr int LDS_BYTES = 131072;
constexpr float INV0 = 1.000000000e+00f, INV1 = 1.939227447e-01f, INV2 = 3.760603093e-02f, INV3 = 7.292664737e-03f, INV4 = 1.414213562e-03f, INV5 = 2.742481757e-04f, INV6 = 5.318295897e-05f, INV7 = 1.031338538e-05f;
constexpr size_t OFF_BIG = 0;
constexpr size_t OFF_MERGED = (size_t)T * FF * 2;
constexpr size_t OFF_XB = OFF_MERGED + (size_t)T * D * 2;
constexpr size_t OFF_LSE = OFF_XB + (size_t)T * D * 2;
constexpr size_t OFF_W = OFF_LSE + (size_t)3 * T * 8 * 4;
constexpr size_t SZ_GU = (size_t)2 * FF * D * 2, SZ_DN = (size_t)D * FF * 2, SZ_IN = (size_t)INW * D * 2, SZ_OUT = (size_t)D * D * 2;
constexpr size_t OFF_GU1 = OFF_W, OFF_DN1 = OFF_GU1 + SZ_GU, OFF_GU2 = OFF_DN1 + SZ_DN, OFF_DN2 = OFF_GU2 + SZ_GU, OFF_WIN = OFF_DN2 + SZ_DN, OFF_WOUT = OFF_WIN + SZ_IN;
constexpr size_t OFF_SS = OFF_WOUT + SZ_OUT;
constexpr size_t OFF_ROPE = OFF_SS + (size_t)4 * T * 4;
constexpr size_t WS_END = OFF_ROPE + (size_t)SEQ * 16 * 4;

struct Args { const float* in[17]; float* out; unsigned char* ws; int ph_lo, ph_hi; };

__device__ __forceinline__ unsigned pk2(float lo, float hi) { return pg8::cvt_pk_bf16(lo, hi); }
__device__ __forceinline__ float wave_sum(float v) {
#pragma unroll
    for (int o = 1; o < 64; o <<= 1) v += __shfl_xor(v, o);
    return v;
}
#define MK_LDS_WAIT() asm volatile("s_waitcnt lgkmcnt(0)" ::: "memory")

__device__ __forceinline__ void p0_weight_item(const float* W0, const float* W1, int kind, int K, int Nsrc, const float* gain0, const float* gain1, bf16_t* WT, MK_LAS float* scr, int item, int nblk, int lane) {
    const int kb = item / nblk, nb = item % nblk, k0 = 64 * kb, n0 = 32 * nb;
    const int R = n0 + (lane & 31);
    const float* src; int col;
    if (kind == 0) { const int n = (R >> 2) & 1; col = 128 * (R >> 8) + 32 * ((R >> 5) & 3) + 8 * ((R >> 3) & 3) + 4 * ((R >> 7) & 1) + (R & 3); src = n ? W1 : W0; }
    else { col = R; src = W0; }
#pragma unroll 8
    for (int i = 0; i < 32; ++i) { const int kk = 2 * i + (lane >> 5); const int k = k0 + kk;
        float g = 1.0f; if (gain0) g = (gain1 && k >= 512) ? gain1[k - 512] : gain0[k];
        scr[kk * 33 + (lane & 31)] = src[(size_t)k * Nsrc + col] * g; }
    MK_LDS_WAIT();
    const int c = lane & 7;
#pragma unroll
    for (int j = 0; j < 4; ++j) { const int n = (lane >> 3) + 8 * j; const MK_LAS float* s = scr + (8 * c) * 33 + n;
        u32x4 o; o.x = pk2(s[0 * 33], s[1 * 33]); o.y = pk2(s[2 * 33], s[3 * 33]); o.z = pk2(s[4 * 33], s[5 * 33]); o.w = pk2(s[6 * 33], s[7 * 33]);
        *(u32x4*)(WT + (size_t)(n0 + n) * K + k0 + 8 * c) = o; }
    MK_LDS_WAIT();
}

__device__ __forceinline__ void phase_prologue(const Args& a, MK_LAS unsigned char* lds, int gw, int NGW, int wave, int lane) {
    MK_LAS float* scr = (MK_LAS float*)(lds + wave * 8448);
    unsigned char* ws = a.ws;
    constexpr int I_GU = (D / 64) * (2 * FF / 32), I_DN = (FF / 64) * (D / 32), I_IN = (D / 64) * (INW / 32), I_OUT = (D / 64) * (D / 32);
    constexpr int NITEMS = 2 * I_GU + 2 * I_DN + I_IN + I_OUT;
    for (int it = gw; it < NITEMS; it += NGW) {
        int r = it; const float *W0, *W1 = nullptr, *g0 = nullptr, *g1 = nullptr; int kind = 1, K = D, Nsrc = D; size_t woff;
        if (r < 2 * I_GU) { const bool s2 = r >= I_GU; r -= s2 ? I_GU : 0; W0 = a.in[s2 ? 13 : 3]; W1 = a.in[s2 ? 14 : 4]; g0 = a.in[s2 ? 12 : 2]; kind = 0; Nsrc = FF; woff = s2 ? OFF_GU2 : OFF_GU1; }
        else if (r < 2 * I_GU + 2 * I_DN) { r -= 2 * I_GU; const bool s2 = r >= I_DN; r -= s2 ? I_DN : 0; W0 = a.in[s2 ? 15 : 5]; K = FF; woff = s2 ? OFF_DN2 : OFF_DN1; }
        else if (r < 2 * I_GU + 2 * I_DN + I_IN) { r -= 2 * I_GU + 2 * I_DN; W0 = a.in[7]; g0 = a.in[6]; Nsrc = INW; woff = OFF_WIN; }
        else { r -= 2 * I_GU + 2 * I_DN + I_IN; W0 = a.in[11]; g0 = a.in[9]; g1 = a.in[10]; woff = OFF_WOUT; }
        const int nblk = (kind == 0 ? 2 * FF : Nsrc) / 32;
        p0_weight_item(W0, W1, kind, K, Nsrc, g0, g1, (bf16_t*)(ws + woff), scr, r, nblk, lane);
    }
    bf16_t* xb = (bf16_t*)(ws + OFF_XB); float* ss = (float*)(ws + OFF_SS);
    for (int row = gw; row < T; row += NGW) {
        const float* xr = row < TP ? a.in[0] + (size_t)row * D : a.in[1] + (size_t)(row - TP) * D;
        float s = 0.f;
#pragma unroll
        for (int j = 0; j < 2; ++j) {
            const f32x4 v0 = *(const f32x4*)(xr + j * 512 + lane * 8), v1 = *(const f32x4*)(xr + j * 512 + lane * 8 + 4);
            s += (v0[0] * v0[0] + v0[1] * v0[1]) + (v0[2] * v0[2] + v0[3] * v0[3]) + (v1[0] * v1[0] + v1[1] * v1[1]) + (v1[2] * v1[2] + v1[3] * v1[3]);
            u32x4 w; w.x = pk2(v0[0], v0[1]); w.y = pk2(v0[2], v0[3]); w.z = pk2(v1[0], v1[1]); w.w = pk2(v1[2], v1[3]);
            *(u32x4*)(xb + (size_t)row * D + j * 512 + lane * 8) = w;
        }
        s = wave_sum(s);
        if (lane == 0) { ss[row] = s; ss[T + row] = 0.f; ss[2 * T + row] = 0.f; ss[3 * T + row] = 0.f; }
    }
    float* rope = (float*)(ws + OFF_ROPE);
    for (int i = gw * 64 + lane; i < SEQ * 8; i += NGW * 64) {
        const int pos = i >> 3, j = i & 7;
        const float inv = j == 0 ? INV0 : j == 1 ? INV1 : j == 2 ? INV2 : j == 3 ? INV3 : j == 4 ? INV4 : j == 5 ? INV5 : j == 6 ? INV6 : INV7;
        const float ang = (float)pos * inv;
        double tr = (double)ang * 0.15915494309189535; tr -= __builtin_floor(tr);
        const float fr = (float)tr;
        rope[pos * 16 + j] = __builtin_amdgcn_cosf(fr); rope[pos * 16 + 8 + j] = __builtin_amdgcn_sinf(fr);
    }
}

__device__ __forceinline__ int crow(int r, int hi) { return (r & 3) + 8 * (r >> 2) + 4 * hi; }
typedef short v4i16_t __attribute__((ext_vector_type(4)));
__device__ __forceinline__ s16x4 vtr(const MK_LAS unsigned char* p) { return __builtin_bit_cast(s16x4, __builtin_amdgcn_ds_read_tr16_b64_v4i16((MK_LAS v4i16_t*)p)); }
#define MK_MFMA32(a, b, c) __builtin_amdgcn_mfma_f32_32x32x16_bf16(a, b, c, 0, 0, 0)

struct TileDesc {
    size_t rowbase;
    int qcol, kcol, vcol;
    int stride, res, t0, hw, L;
    bf16_t* out; int out_ld, out_col;
    float* lse;
    float sink_l2; int has_sink;
};
constexpr float ATT_THR = 8.0f;

__device__ __forceinline__ void attn_tile(const bf16_t* __restrict__ proj, const TileDesc& d, MK_LAS unsigned char* wl, int lane) {
    const int r32 = lane & 31, hi = lane >> 5;
    MK_LAS float* wsf = (MK_LAS float*)(wl + 4096);
    const int nkt = d.hw / 16 + 1;
    const int kt_lo = d.t0 >= d.hw ? 0 : ((d.hw - d.t0) >> 5);
    int kt_hi = (d.L - d.t0 + d.hw) >> 5; kt_hi = kt_hi < nkt ? kt_hi : nkt;
    const size_t tokstride = (size_t)d.stride * INW;
    const bf16_t* seq0 = proj + (d.rowbase + d.res) * INW;
    const bf16_t* qp = seq0 + (size_t)(d.t0 + r32) * tokstride + d.qcol + hi * 8;
    bf16x8 qr[4];
#pragma unroll
    for (int d0 = 0; d0 < 4; ++d0) qr[d0] = *(const bf16x8*)(qp + d0 * 16);
    const bf16_t* kbase = seq0 + d.kcol + hi * 8 + (size_t)r32 * tokstride;
    const bf16_t* vbase = seq0 + d.vcol + (lane & 7) * 8 + (size_t)(lane >> 3) * tokstride;
    const int vwoff = ((lane & 7) >> 2) * 2048 + (lane >> 3) * 64 + (lane & 3) * 16;
    const int vrbase = ((lane >> 4) & 1) * 32 + (lane & 3) * 8 + (4 * hi + ((lane & 15) >> 2)) * 64;
    float mhat = -1.0e4f, lsum = 0.f;
    f32x16 o0 = {}, o1 = {};
    bf16x8 kn[4]; u32x4 vn[4];
    {
        const size_t so = (size_t)(d.t0 - d.hw + 32 * kt_lo) * tokstride;
#pragma unroll
        for (int d0 = 0; d0 < 4; ++d0) kn[d0] = *(const bf16x8*)(kbase + so + d0 * 16);
#pragma unroll
        for (int i = 0; i < 4; ++i) vn[i] = *(const u32x4*)(vbase + so + (size_t)(i * 8) * tokstride);
    }
    for (int kt = kt_lo; kt < kt_hi; ++kt) {
        bf16x8 kf[4]; u32x4 vv[4];
#pragma unroll
        for (int i = 0; i < 4; ++i) { kf[i] = kn[i]; vv[i] = vn[i]; }
        if (kt + 1 < kt_hi) {
            const size_t so = (size_t)(d.t0 - d.hw + 32 * (kt + 1)) * tokstride;
#pragma unroll
            for (int d0 = 0; d0 < 4; ++d0) kn[d0] = *(const bf16x8*)(kbase + so + d0 * 16);
#pragma unroll
            for (int i = 0; i < 4; ++i) vn[i] = *(const u32x4*)(vbase + so + (size_t)(i * 8) * tokstride);
        }
        f32x16 p = {};
#pragma unroll
        for (int d0 = 0; d0 < 4; ++d0) p = MK_MFMA32(kf[d0], qr[d0], p);
#pragma unroll
        for (int i = 0; i < 4; ++i) *(MK_LAS u32x4*)(wl + vwoff + i * 512) = vv[i];
        if (kt == 0) {
#pragma unroll
            for (int r = 0; r < 16; ++r) if (crow(r, hi) < r32) p[r] = -1.0e30f;
        }
        if (kt == nkt - 1) {
#pragma unroll
            for (int r = 0; r < 16; ++r) if (crow(r, hi) > r32) p[r] = -1.0e30f;
        }
        float rm = __builtin_fmaxf(p[0], p[1]);
#pragma unroll
        for (int r = 2; r < 16; ++r) rm = __builtin_fmaxf(rm, p[r]);
        rm = __builtin_fmaxf(rm, __shfl_xor(rm, 32));
        if (__any(rm > mhat + ATT_THR)) {
            const float mnew = __builtin_fmaxf(mhat, rm), f = __builtin_amdgcn_exp2f(mhat - mnew);
            lsum *= f; mhat = mnew;
            if (hi == 0) wsf[r32] = f;
            MK_LDS_WAIT();
#pragma unroll
            for (int g = 0; g < 4; ++g) { const f32x4 w4 = *(const MK_LAS f32x4*)(wsf + 8 * g + 4 * hi);
#pragma unroll
                for (int j = 0; j < 4; ++j) { o0[4 * g + j] *= w4[j]; o1[4 * g + j] *= w4[j]; } }
        }
        float sacc = 0.f;
#pragma unroll
        for (int r = 0; r < 16; ++r) { p[r] = __builtin_amdgcn_exp2f(p[r] - mhat); sacc += p[r]; }
        lsum += sacc;
        u32x4 pw0, pw1;
        pw0.x = pk2(p[0], p[1]); pw0.y = pk2(p[2], p[3]); pw0.z = pk2(p[4], p[5]); pw0.w = pk2(p[6], p[7]);
        pw1.x = pk2(p[8], p[9]); pw1.y = pk2(p[10], p[11]); pw1.z = pk2(p[12], p[13]); pw1.w = pk2(p[14], p[15]);
        MK_LDS_WAIT();
        const MK_LAS unsigned char* vp = wl + vrbase;
#define MK_VFR(off) __builtin_shufflevector(vtr(vp + (off)), vtr(vp + (off) + 512), 0, 1, 2, 3, 4, 5, 6, 7)
        const bf16x8 v00 = MK_VFR(0), v01 = MK_VFR(2048), v10 = MK_VFR(1024), v11 = MK_VFR(2048 + 1024);
#undef MK_VFR
        o0 = MK_MFMA32(__builtin_bit_cast(bf16x8, pw0), v00, o0); o1 = MK_MFMA32(__builtin_bit_cast(bf16x8, pw0), v01, o1);
        o0 = MK_MFMA32(__builtin_bit_cast(bf16x8, pw1), v10, o0); o1 = MK_MFMA32(__builtin_bit_cast(bf16x8, pw1), v11, o1);
    }
    float ltot = lsum + __shfl_xor(lsum, 32);
    if (d.has_sink) ltot += __builtin_amdgcn_exp2f(d.sink_l2 - mhat);
    const float rl = 1.0f / ltot;
    if (hi == 0) wsf[r32] = rl;
    MK_LDS_WAIT();
    MK_LAS bf16_t* stg = (MK_LAS bf16_t*)wl;
#pragma unroll
    for (int g = 0; g < 4; ++g) { const f32x4 w4 = *(const MK_LAS f32x4*)(wsf + 8 * g + 4 * hi);
#pragma unroll
        for (int j = 0; j < 4; ++j) { const int r = 4 * g + j, orow = crow(r, hi);
            stg[orow * 64 + r32] = (bf16_t)(pk2(o0[r] * w4[j], 0.f) & 0xffffu); stg[orow * 64 + 32 + r32] = (bf16_t)(pk2(o1[r] * w4[j], 0.f) & 0xffffu); } }
    MK_LDS_WAIT();
#pragma unroll
    for (int i = 0; i < 4; ++i) { const int row = i * 8 + (lane >> 3), ch = lane & 7;
        *(u32x4*)(d.out + (d.rowbase + d.res + (size_t)d.stride * (d.t0 + row)) * d.out_ld + d.out_col + ch * 8) = *(const MK_LAS u32x4*)(stg + row * 64 + ch * 8); }
    if (d.lse && hi == 0) d.lse[(d.rowbase + d.res + (size_t)d.stride * (d.t0 + r32)) * 8] = mhat + __builtin_log2f(ltot);
    MK_LDS_WAIT();
}

__device__ __forceinline__ void phase_attention(const Args& a, MK_LAS unsigned char* lds, int gw, int NGW, int wave, int lane) {
    MK_LAS unsigned char* wl = lds + wave * 4352;
    unsigned char* ws = a.ws;
    const bf16_t* proj = (const bf16_t*)(ws + OFF_BIG);
    bf16_t* merged = (bf16_t*)(ws + OFF_MERGED); bf16_t* ob23 = (bf16_t*)(ws + OFF_XB); float* lse = (float*)(ws + OFF_LSE);
    constexpr int NA = 24 * 8 * 128, NB = 3 * NA;
    for (int it = gw; it < NA + NB; it += NGW) {
        TileDesc d;
        if (it < NA) {
            const int ts = it & 127, hq = (it >> 7) & 7, n = it >> 10;
            d.rowbase = (size_t)n * SEQ; d.qcol = hq * 64; d.kcol = 512 + (hq >> 2) * 64; d.vcol = 640 + (hq >> 2) * 64;
            d.stride = 1; d.res = 0; d.t0 = ts * 32; d.hw = 128; d.L = SEQ;
            d.out = merged; d.out_ld = 1024; d.out_col = hq * 64; d.lse = nullptr;
            d.sink_l2 = a.in[8][hq] * 1.4426950408889634f; d.has_sink = 1;
        } else {
            const int ib = it - NA; const int g = ib / NA, rem = ib - g * NA;
            const int f = rem & 127, h = (rem >> 7) & 7, n = rem >> 10;
            const int sh = 2 * g, dd = 1 << sh;
            d.rowbase = (size_t)n * SEQ; d.qcol = 768 + h * 64; d.kcol = 1280 + h * 64; d.vcol = 1792 + h * 64;
            d.stride = dd; d.res = f & (dd - 1); d.t0 = (f >> sh) * 32; d.hw = 64; d.L = SEQ >> sh;
            if (g == 0) { d.out = merged; d.out_ld = 1024; d.out_col = 512 + h * 64; }
            else { d.out = ob23 + (size_t)(g - 1) * T * 512; d.out_ld = 512; d.out_col = h * 64; }
            d.lse = lse + (size_t)g * T * 8 + h; d.sink_l2 = 0.f; d.has_sink = 0;
        }
        attn_tile(proj, d, wl, lane);
    }
}

__device__ __forceinline__ void unpack8(const u32x4 w, float (&v)[8]) {
    v[0] = __uint_as_float(w.x << 16); v[1] = __uint_as_float(w.x & 0xffff0000u); v[2] = __uint_as_float(w.y << 16); v[3] = __uint_as_float(w.y & 0xffff0000u);
    v[4] = __uint_as_float(w.z << 16); v[5] = __uint_as_float(w.z & 0xffff0000u); v[6] = __uint_as_float(w.w << 16); v[7] = __uint_as_float(w.w & 0xffff0000u);
}
__device__ __forceinline__ u32x4 pack8(const float (&v)[8], float s) { u32x4 w; w.x = pk2(v[0] * s, v[1] * s); w.y = pk2(v[2] * s, v[3] * s); w.z = pk2(v[4] * s, v[5] * s); w.w = pk2(v[6] * s, v[7] * s); return w; }
__device__ __forceinline__ void phase_finalize(const Args& a, int gw, int NGW, int lane) {
    unsigned char* ws = a.ws;
    bf16_t* merged = (bf16_t*)(ws + OFF_MERGED); const bf16_t* ob2 = (const bf16_t*)(ws + OFF_XB); const bf16_t* ob3 = ob2 + (size_t)T * 512; const float* lse = (const float*)(ws + OFF_LSE);
    const int h = lane >> 3;
    for (int row = gw; row < T; row += NGW) {
        bf16_t* mr = merged + (size_t)row * 1024;
        float va[8], b1[8], b2[8], b3[8];
        unpack8(*(const u32x4*)(mr + lane * 8), va);
        unpack8(*(const u32x4*)(mr + 512 + lane * 8), b1);
        unpack8(*(const u32x4*)(ob2 + (size_t)row * 512 + lane * 8), b2);
        unpack8(*(const u32x4*)(ob3 + (size_t)row * 512 + lane * 8), b3);
        const float l1 = lse[(size_t)row * 8 + h], l2 = lse[(size_t)T * 8 + (size_t)row * 8 + h], l3 = lse[(size_t)2 * T * 8 + (size_t)row * 8 + h];
        const float mx = __builtin_fmaxf(l1, __builtin_fmaxf(l2, l3));
        const float e1 = __builtin_amdgcn_exp2f(l1 - mx), e2 = __builtin_amdgcn_exp2f(l2 - mx), e3 = __builtin_amdgcn_exp2f(l3 - mx), ri = 1.0f / (e1 + e2 + e3);
        const float w1 = e1 * ri, w2 = e2 * ri, w3 = e3 * ri;
        float sa = 0.f, sb = 0.f;
#pragma unroll
        for (int j = 0; j < 8; ++j) { b1[j] = w1 * b1[j] + w2 * b2[j] + w3 * b3[j]; sa += va[j] * va[j]; sb += b1[j] * b1[j]; }
        sa = wave_sum(sa); sb = wave_sum(sb);
        const float ra = __builtin_amdgcn_rsqf(sa * (1.0f / 512.0f) + 1e-6f), rb = __builtin_amdgcn_rsqf(sb * (1.0f / 512.0f) + 1e-6f);
        *(u32x4*)(mr + lane * 8) = pack8(va, ra);
        *(u32x4*)(mr + 512 + lane * 8) = pack8(b1, rb);
    }
}

__device__ __forceinline__ void phase_final_norm(const Args& a, int gw, int NGW, int lane) {
    const float* ss = (const float*)(a.ws + OFF_SS) + (size_t)3 * T; const float* gain = a.in[16];
    f32x4 g[4];
#pragma unroll
    for (int j = 0; j < 4; ++j) g[j] = *(const f32x4*)(gain + j * 256 + lane * 4);
    for (int row = gw; row < T; row += NGW) {
        float* xr = a.out + (size_t)row * D; const float rs = pg8::rstd_of(ss[row]);
#pragma unroll
        for (int j = 0; j < 4; ++j) { f32x4 v = *(const f32x4*)(xr + j * 256 + lane * 4); v = v * rs * g[j]; *(f32x4*)(xr + j * 256 + lane * 4) = v; }
    }
}

constexpr int NPHASE = 10;
#ifndef MK_MASK
#define MK_MASK 0x3ff
#endif
#define MK_ON(p) ((MK_MASK >> (p)) & 1)
__global__ __launch_bounds__(512) void mk_fwd(const Args a) {
    extern __shared__ __attribute__((aligned(16))) unsigned char lds_raw[];
    MK_LAS unsigned char* lds = (MK_LAS unsigned char*)lds_raw;
    cg::grid_group grid = cg::this_grid();
    for (int ph = a.ph_lo; ph < a.ph_hi; ++ph) {
        int tid = threadIdx.x; asm volatile("" : "+v"(tid));
        const int lane = tid & 63, wave = __builtin_amdgcn_readfirstlane(tid >> 6);
        int G = gridDim.x, bid = blockIdx.x; asm volatile("" : "+s"(G), "+s"(bid));
        const int vcu = (bid & 7) * (G >> 3) + (bid >> 3);
        const int gw = vcu * 8 + wave, NGW = G * 8;
        unsigned char* ws = a.ws; asm volatile("" : "+s"(ws));
        float* ss = (float*)(ws + OFF_SS);
        if (MK_ON(0) && ph == 0) phase_prologue(a, lds, gw, NGW, wave, lane);
        else if (MK_ON(1) && (ph == 1 || ph == 7)) {
            const bool second = ph == 7;
            pg8::Gemm g; g.A = (const bf16_t*)(ws + OFF_XB); g.Bt = (const bf16_t*)(ws + (second ? OFF_GU2 : OFF_GU1)); g.M = T; g.N = 2 * FF; g.K = D;
            pg8::StaticOrder S; S.init(T, 2 * FF, G, bid);
            pg8::EpiGateUp E; E.H = (bf16_t*)(ws + OFF_BIG); E.ss = ss + (second ? 2 * (size_t)T : 0);
            pg8::gemm_phase<pg8::EpiGateUp, pg8::StaticOrder, true, true>(lds, g, S, E, tid);
        } else if (MK_ON(2) && (ph == 2 || ph == 6 || ph == 8)) {
            pg8::Gemm g; pg8::EpiResid E; E.out = a.out; E.split = TP;
            if (ph == 2) { g.A = (const bf16_t*)(ws + OFF_BIG); g.Bt = (const bf16_t*)(ws + OFF_DN1); g.K = FF; E.res_lo = a.in[0]; E.res_hi = a.in[1]; E.xb = (bf16_t*)(ws + OFF_XB); E.ssout = ss + T; E.alpha = 0.5f; }
            else if (ph == 6) { g.A = (const bf16_t*)(ws + OFF_MERGED); g.Bt = (const bf16_t*)(ws + OFF_WOUT); g.K = D; E.res_lo = a.out; E.res_hi = a.out + (size_t)TP * D; E.xb = (bf16_t*)(ws + OFF_XB); E.ssout = ss + 2 * (size_t)T; E.alpha = 1.0f; }
            else { g.A = (const bf16_t*)(ws + OFF_BIG); g.Bt = (const bf16_t*)(ws + OFF_DN2); g.K = FF; E.res_lo = a.out; E.res_hi = a.out + (size_t)TP * D; E.xb = nullptr; E.ssout = ss + 3 * (size_t)T; E.alpha = 0.5f; }
            g.M = T; g.N = D;
            pg8::StaticOrder S; S.init(T, D, G, bid);
            pg8::gemm_phase<pg8::EpiResid, pg8::StaticOrder, true, true>(lds, g, S, E, tid);
        } else if (MK_ON(3) && ph == 3) {
            pg8::Gemm g; g.A = (const bf16_t*)(ws + OFF_XB); g.Bt = (const bf16_t*)(ws + OFF_WIN); g.M = T; g.N = INW; g.K = D;
            pg8::StaticOrder S; S.init(T, INW, G, bid);
            pg8::EpiQkv E; E.P = (bf16_t*)(ws + OFF_BIG); E.ss = ss + T; E.rope = (const float*)(ws + OFF_ROPE);
            pg8::gemm_phase<pg8::EpiQkv, pg8::StaticOrder, true, true>(lds, g, S, E, tid);
        } else if (MK_ON(4) && ph == 4) phase_attention(a, lds, gw, NGW, wave, lane);
        else if (MK_ON(5) && ph == 5) phase_finalize(a, gw, NGW, lane);
        else if (MK_ON(9) && ph == 9) phase_final_norm(a, gw, NGW, lane);
        if (ph + 1 < a.ph_hi) grid.sync();
    }
}
}

#ifndef MK_N_LAUNCHES
#define MK_N_LAUNCHES 1
#endif
extern "C" void kernel_launch(void* const* d_in, const int* in_sizes, int n_in, void* d_out, int out_size, void* d_ws, size_t ws_size, hipStream_t stream) {
    static int grid = 0;
    if (grid == 0) {
        if (n_in != 17 || out_size != mk::T * mk::D || ws_size < mk::WS_END) { fprintf(stderr, "kernel_launch: unexpected shapes (n_in %d out %d ws %zu need %zu)\n", n_in, out_size, ws_size, (size_t)mk::WS_END); grid = -1; return; }
        int dev = 0, cus = 0, per_cu = 0;
        hipGetDevice(&dev); hipDeviceGetAttribute(&cus, hipDeviceAttributeMultiprocessorCount, dev);
        if (hipFuncSetAttribute((const void*)mk::mk_fwd, hipFuncAttributeMaxDynamicSharedMemorySize, mk::LDS_BYTES) != hipSuccess) { fprintf(stderr, "kernel_launch: hipFuncSetAttribute failed\n"); grid = -1; return; }
        if (hipOccupancyMaxActiveBlocksPerMultiprocessor(&per_cu, (const void*)mk::mk_fwd, 512, mk::LDS_BYTES) != hipSuccess || per_cu < 1) { fprintf(stderr, "kernel_launch: occupancy query says %d\n", per_cu); per_cu = 1; }
        (void)hipGetLastError();
        grid = cus * 1;
        if (grid % 8) grid -= grid % 8;
    }
    if (grid < 0) return;
    mk::Args a{};
    for (int i = 0; i < 17; ++i) a.in[i] = (const float*)d_in[i];
    a.out = (float*)d_out; a.ws = (unsigned char*)d_ws;
#if MK_N_LAUNCHES == 1
    a.ph_lo = 0; a.ph_hi = 10;
    void* args[] = {(void*)&a};
    hipError_t e = hipLaunchCooperativeKernel((const void*)mk::mk_fwd, dim3(grid), dim3(512), args, mk::LDS_BYTES, stream);
    if (e != hipSuccess) fprintf(stderr, "kernel_launch: cooperative launch failed: %s (grid %d)\n", hipGetErrorString(e), grid);
#else
    for (int p = 0; p < 10; ++p) { a.ph_lo = p; a.ph_hi = p + 1; hipLaunchKernelGGL(mk::mk_fwd, dim3(grid), dim3(512), mk::LDS_BYTES, stream, a); }
#endif
}
```

```cpp
#include <hip/hip_runtime.h>
#include <hip/hip_cooperative_groups.h>
#include <cstdio>
#include <cstdint>
namespace cg = cooperative_groups;
namespace pg8 {
#define PG8_LAS __attribute__((address_space(3)))
typedef unsigned short bf16_t;
typedef short bf16x8 __attribute__((ext_vector_type(8)));
typedef float f32x4 __attribute__((ext_vector_type(4)));
typedef unsigned u32x4 __attribute__((ext_vector_type(4)));
constexpr int BM = 256, BK = 64, HALF = 128, HTB = HALF * BK * 2  , STAGE_BYTES = 8 * HTB, NXCD = 8, WGM = 8;

__host__ __device__ __forceinline__ int lds_byte(int r, int c) { const int st = (r >> 4) * 2 + (c >> 5), rr = r & 15, cc = c & 31, ob = rr * 64 + cc * 2; return st * 1024 + (ob ^ (((ob >> 9) & 1) << 5)); }
__host__ __device__ __forceinline__ void stage_rc(int b, int& R, int& C) { const int st = b / 1024, sb = b % 1024, swz = sb ^ (((sb >> 9) & 1) << 5); R = (st >> 1) * 16 + swz / 64; C = (st & 1) * 32 + (swz % 64) / 2; }
__host__ __device__ __forceinline__ int perm32(int rho) { const int n = rho >> 4, i = rho & 15; return 8 * (i >> 2) + 4 * n + (i & 3); }

struct Unit { int pm, pn; };
struct Gemm { const bf16_t* A; const bf16_t* Bt; int M, N, K; };

struct StaticOrder {
    int nM, nN, nwg, G, c;
    __host__ __device__ void init(int M, int N, int G_, int c_) { nM = M / BM; nN = N / BM; nwg = nM * nN; G = G_; c = c_; }
    __host__ __device__ bool next(int i, Unit& u) const {
        const long L = (long)i * G + c; if (L >= nwg) return false;
        int wgid = (int)L; { const int q = nwg / NXCD, r = nwg % NXCD, xcd = wgid % NXCD, off = wgid / NXCD; wgid = (xcd < r ? xcd * (q + 1) : r * (q + 1) + (xcd - r) * q) + off; }
        const int nig = WGM * nN, gid = wgid / nig, fm = gid * WGM, gsz = (nM - fm) < WGM ? (nM - fm) : WGM;
        u.pm = fm + ((wgid % nig) % gsz); u.pn = (wgid % nig) / gsz; return true;
    }
    __device__ __forceinline__ void a_ready(const Unit&) const {}
    __device__ __forceinline__ void done(const Unit&) const {}
};
__device__ __forceinline__ unsigned cvt_pk_bf16(float lo, float hi) { unsigned r; asm volatile("v_cvt_pk_bf16_f32 %0, %1, %2" : "=v"(r) : "v"(lo), "v"(hi)); return r; }

__device__ __forceinline__ float silu_f(float x) { return x * __builtin_amdgcn_rcpf(1.0f + __builtin_amdgcn_exp2f(-1.4426950408889634f * x)); }
__device__ __forceinline__ float rstd_of(float ss) { return __builtin_amdgcn_rsqf(ss * (1.0f / 1024.0f) + 1e-6f); }

struct EpiGateUp {
    static constexpr bool PERM = true, AFTER_DRAIN = false;
    bf16_t* H; const float* ss;
    __device__ __forceinline__ void operator()(const f32x4 (&acc)[2][2][4][2], const Unit& u, int wr, int wc, int fr, int fq) const {
        const int row0 = u.pm * BM + wr * 64 + fr, hcol = u.pn * 128 + wc * 32 + fq * 8;
#pragma unroll
        for (int ai = 0; ai < 2; ++ai)
#pragma unroll
            for (int m = 0; m < 4; ++m) {
                const int row = row0 + ai * HALF + m * 16; const float rs = rstd_of(ss[row]);
                const f32x4 g0 = acc[ai][0][m][0] * rs, g1 = acc[ai][1][m][0] * rs, u0 = acc[ai][0][m][1] * rs, u1 = acc[ai][1][m][1] * rs;
                u32x4 w;
                w.x = cvt_pk_bf16(silu_f(g0[0]) * u0[0], silu_f(g0[1]) * u0[1]); w.y = cvt_pk_bf16(silu_f(g0[2]) * u0[2], silu_f(g0[3]) * u0[3]);
                w.z = cvt_pk_bf16(silu_f(g1[0]) * u1[0], silu_f(g1[1]) * u1[1]); w.w = cvt_pk_bf16(silu_f(g1[2]) * u1[2], silu_f(g1[3]) * u1[3]);
                *(u32x4*)(H + (size_t)row * 2816 + hcol) = w;
                asm volatile("" ::: "memory");
            }
    }
};

struct EpiResid {
    static constexpr bool PERM = true, AFTER_DRAIN = false;
    const float* res_lo; const float* res_hi; int split;
    float* out; bf16_t* xb; float* ssout; float alpha;
    __device__ __forceinline__ void operator()(const f32x4 (&acc)[2][2][4][2], const Unit& u, int wr, int wc, int fr, int fq) const {
        const int row0 = u.pm * BM + wr * 64 + fr, col0 = u.pn * BM + wc * 32 + fq * 8;
        const float* rbase = (u.pm * BM < split) ? res_lo : res_hi - (size_t)split * 1024;
#pragma unroll
        for (int ai = 0; ai < 2; ++ai) {
            f32x4 rr[4][2][2];
#pragma unroll
            for (int m = 0; m < 4; ++m)
#pragma unroll
                for (int bj = 0; bj < 2; ++bj) { const size_t off = (size_t)(row0 + ai * HALF + m * 16) * 1024 + col0 + bj * HALF;
                    rr[m][bj][0] = *(const f32x4*)(rbase + off); rr[m][bj][1] = *(const f32x4*)(rbase + off + 4); }
#pragma unroll
            for (int m = 0; m < 4; ++m) {
                const int row = row0 + ai * HALF + m * 16; float s = 0.f;
#pragma unroll
                for (int bj = 0; bj < 2; ++bj) {
                    const size_t off = (size_t)row * 1024 + col0 + bj * HALF;
                    const f32x4 v0 = rr[m][bj][0] + alpha * acc[ai][bj][m][0], v1 = rr[m][bj][1] + alpha * acc[ai][bj][m][1];
                    *(f32x4*)(out + off) = v0; *(f32x4*)(out + off + 4) = v1;
                    if (xb) { u32x4 w; w.x = cvt_pk_bf16(v0[0], v0[1]); w.y = cvt_pk_bf16(v0[2], v0[3]); w.z = cvt_pk_bf16(v1[0], v1[1]); w.w = cvt_pk_bf16(v1[2], v1[3]); *(u32x4*)(xb + off) = w; }
                    s += (v0[0] * v0[0] + v0[1] * v0[1]) + (v0[2] * v0[2] + v0[3] * v0[3]) + (v1[0] * v1[0] + v1[1] * v1[1]) + (v1[2] * v1[2] + v1[3] * v1[3]);
                }
                s += __shfl_xor(s, 16); s += __shfl_xor(s, 32);
                if (fq == 0) atomicAdd(ssout + row, s);
            }
            asm volatile("" ::: "memory");
        }
    }
};

struct EpiQkv {
    static constexpr bool PERM = true, AFTER_DRAIN = false;
    bf16_t* P; const float* ss; const float* rope;
    __device__ __forceinline__ void operator()(const f32x4 (&acc)[2][2][4][2], const Unit& u, int wr, int wc, int fr, int fq) const {
        const int row0 = u.pm * BM + wr * 64 + fr, col0 = u.pn * BM + wc * 32 + fq * 8; const int pn = u.pn;
        const bool isq = (pn <= 1) || (pn == 3) || (pn == 4);
        const float qs = isq ? 0.125f * 1.4426950408889634f : 1.0f;
#pragma unroll
        for (int ai = 0; ai < 2; ++ai)
#pragma unroll
            for (int m = 0; m < 4; ++m) {
                const int row = row0 + ai * HALF + m * 16; const float rs = rstd_of(ss[row]) * qs;
                const float* rp = rope + (size_t)(row & 4095) * 16;
#pragma unroll
                for (int bj = 0; bj < 2; ++bj) {
                    f32x4 v0 = acc[ai][bj][m][0] * rs, v1 = acc[ai][bj][m][1] * rs;
                    const bool rot = ((pn <= 6) && !(pn == 2 && bj == 1)) && ((wc & 1) == 0);
                    if (rot) {
                        const float sg = fq == 0 ? -1.0f : 1.0f; const bool act = fq < 2;
                        { f32x4 o0;
#pragma unroll
                          for (int j = 0; j < 4; ++j) o0[j] = __shfl_xor(v0[j], 16);
                          if (act) { const f32x4 c0 = *(const f32x4*)(rp), s0 = *(const f32x4*)(rp + 8); v0 = v0 * c0 + sg * (o0 * s0); } }
                        { f32x4 o1;
#pragma unroll
                          for (int j = 0; j < 4; ++j) o1[j] = __shfl_xor(v1[j], 16);
                          if (act) { const f32x4 c1 = *(const f32x4*)(rp + 4), s1 = *(const f32x4*)(rp + 12); v1 = v1 * c1 + sg * (o1 * s1); } }
                    }
                    u32x4 w; w.x = cvt_pk_bf16(v0[0], v0[1]); w.y = cvt_pk_bf16(v0[2], v0[3]); w.z = cvt_pk_bf16(v1[0], v1[1]); w.w = cvt_pk_bf16(v1[2], v1[3]);
                    *(u32x4*)(P + (size_t)row * 2304 + col0 + bj * HALF) = w;
                    asm volatile("" ::: "memory");
                }
            }
    }
};
template <class Epi, class Sched, bool ALIGN_EPI = false, bool SP2 = false>
__device__ __forceinline__ void gemm_phase(PG8_LAS unsigned char* lds, const Gemm g, const Sched& S, const Epi& E, const int tid) {
    const int  wid = __builtin_amdgcn_readfirstlane(tid >> 6), lane = tid & 63, wr = wid >> 2, wc = wid & 3, fr = lane & 15, fq = lane >> 4;
    const int K = g.K, nt = K / BK;
    unsigned voffA[2], voffB[2];
#pragma unroll
    for (int i = 0; i < 2; ++i) { int R, C; stage_rc(tid * 16 + i * 8192, R, C); const int Rb = Epi::PERM ? ((R & ~31) + perm32(R & 31)) : R;
        voffA[i] = (unsigned)(R * K + C) * 2u; voffB[i] = (unsigned)(Rb * K + C) * 2u; }
    const size_t kstep = (size_t)(BK * 2);
    const size_t hstep = (size_t)HALF * K * 2;
    const size_t tstep = 2 * hstep;
    const unsigned ldsw = (unsigned)wid * 1024u;
    const int aoff = lds_byte(wr * 64 + fr, fq * 8), boff = lds_byte(wc * 32 + fr, fq * 8);
#define PG8_SA(b, h) (((b) * 2 + (h)) * HTB)
#define PG8_SB(b, h) ((4 + (b) * 2 + (h)) * HTB)
#define PG8_STAGE(bufoff, gbase, voff) do { _Pragma("unroll") for (int _i = 0; _i < 2; ++_i) \
        __builtin_amdgcn_global_load_lds((const unsigned*)((const char*)(gbase) + (voff)[_i]), (PG8_LAS unsigned*)(lds + (bufoff) + ldsw + _i * 8192), 16, 0, 0); } while (0)
#define PG8_LDA(dst, b, h) do { _Pragma("unroll") for (int m = 0; m < 4; ++m) _Pragma("unroll") for (int k = 0; k < 2; ++k) dst[m][k] = *(const PG8_LAS bf16x8*)(lds + PG8_SA(b, h) + aoff + m * 2048 + k * 1024); } while (0)
#define PG8_LDB(dst, b, h) do { _Pragma("unroll") for (int n = 0; n < 2; ++n) _Pragma("unroll") for (int k = 0; k < 2; ++k) dst[n][k] = *(const PG8_LAS bf16x8*)(lds + PG8_SB(b, h) + boff + n * 2048 + k * 1024); } while (0)
#define PG8_MMA(ai, bj, At, Bt) do { __builtin_amdgcn_s_setprio(1); _Pragma("unroll") for (int m = 0; m < 4; ++m) _Pragma("unroll") for (int n = 0; n < 2; ++n) _Pragma("unroll") for (int k = 0; k < 2; ++k) \
        acc[ai][bj][m][n] = __builtin_amdgcn_mfma_f32_16x16x32_bf16(Bt[n][k], At[m][k], acc[ai][bj][m][n], 0, 0, 0); __builtin_amdgcn_s_setprio(0); } while (0)
#define PG8_WAIT_V(n) asm volatile("s_waitcnt vmcnt(" #n ")" ::: "memory")
#define PG8_WAIT_L(n) asm volatile("s_waitcnt lgkmcnt(" #n ")" ::: "memory")
#define PG8_BAR __builtin_amdgcn_s_barrier()
#define PG8_SCHED __builtin_amdgcn_sched_barrier(0)
    Unit cur, nxt; int ui = 0;
    if (!S.next(0, cur)) return;
    f32x4 acc[2][2][4][2];
#pragma unroll
    for (int a = 0; a < 2; ++a)
#pragma unroll
        for (int b = 0; b < 2; ++b)
#pragma unroll
            for (int m = 0; m < 4; ++m)
#pragma unroll
                for (int n = 0; n < 2; ++n) acc[a][b][m][n] = (f32x4){0.f, 0.f, 0.f, 0.f};
    bf16x8 At[4][2], B0[2][2], B1[2][2];
    const char* cA = (const char*)g.A + (size_t)cur.pm * tstep; const char* cB = (const char*)g.Bt + (size_t)cur.pn * tstep;
    S.a_ready(cur);
    if constexpr (SP2) {
        PG8_STAGE(PG8_SB(0, 0), cB, voffB); PG8_STAGE(PG8_SB(0, 1), cB + hstep, voffB); PG8_STAGE(PG8_SA(0, 0), cA, voffA); PG8_STAGE(PG8_SA(0, 1), cA + hstep, voffA);
        if (wr == 1) PG8_BAR;
        PG8_WAIT_V(2); PG8_BAR;
        PG8_STAGE(PG8_SB(1, 0), cB + kstep, voffB); PG8_STAGE(PG8_SA(1, 0), cA + kstep, voffA); PG8_STAGE(PG8_SB(1, 1), cB + hstep + kstep, voffB);
        PG8_WAIT_V(6); PG8_BAR;
    } else {
        PG8_STAGE(PG8_SB(0, 0), cB, voffB); PG8_STAGE(PG8_SA(0, 0), cA, voffA); PG8_STAGE(PG8_SB(0, 1), cB + hstep, voffB); PG8_STAGE(PG8_SA(0, 1), cA + hstep, voffA);
        if (wr == 1) PG8_BAR;
        PG8_WAIT_V(4); PG8_BAR;
        PG8_STAGE(PG8_SB(1, 0), cB + kstep, voffB); PG8_STAGE(PG8_SA(1, 0), cA + kstep, voffA); PG8_STAGE(PG8_SB(1, 1), cB + hstep + kstep, voffB);
        PG8_WAIT_V(6); PG8_BAR;
    }
    for (;;) {
        const bool has_next = S.next(ui + 1, nxt);
        const char* nA = has_next ? (const char*)g.A + (size_t)nxt.pm * tstep : cA; const char* nB = has_next ? (const char*)g.Bt + (size_t)nxt.pn * tstep : cB;
        for (int t = 0; t < nt; t += 2) {
            const bool last = (t == nt - 2);
            const char* a1 = cA + (size_t)(t + 1) * kstep;
            const char* a2 = last ? nA : cA + (size_t)(t + 2) * kstep; const char* b2 = last ? nB : cB + (size_t)(t + 2) * kstep;
            const char* a3 = a2 + kstep; const char* b3 = b2 + kstep;
            if (last && has_next) S.a_ready(nxt);
            if constexpr (SP2) {
            PG8_LDB(B0, 0, 0); PG8_LDB(B1, 0, 1); PG8_SCHED; PG8_LDA(At, 0, 0); PG8_STAGE(PG8_SA(1, 1), a1 + hstep, voffA);
            PG8_WAIT_V(8); PG8_WAIT_L(0); PG8_BAR; PG8_MMA(0, 0, At, B0); PG8_MMA(0, 1, At, B1); PG8_BAR; PG8_SCHED;
            PG8_LDA(At, 0, 1); PG8_STAGE(PG8_SB(0, 0), b2, voffB); PG8_STAGE(PG8_SB(0, 1), b2 + hstep, voffB); PG8_STAGE(PG8_SA(0, 0), a2, voffA);
            PG8_WAIT_V(8); PG8_WAIT_L(0); PG8_BAR; PG8_MMA(1, 0, At, B0); PG8_MMA(1, 1, At, B1); PG8_BAR; PG8_SCHED;
            PG8_LDB(B0, 1, 0); PG8_LDB(B1, 1, 1); PG8_SCHED; PG8_LDA(At, 1, 0); PG8_STAGE(PG8_SA(0, 1), a2 + hstep, voffA);
            PG8_WAIT_V(8); PG8_WAIT_L(0); PG8_BAR; PG8_MMA(0, 0, At, B0); PG8_MMA(0, 1, At, B1); PG8_BAR; PG8_SCHED;
            PG8_LDA(At, 1, 1); PG8_STAGE(PG8_SB(1, 0), b3, voffB); PG8_STAGE(PG8_SB(1, 1), b3 + hstep, voffB); PG8_STAGE(PG8_SA(1, 0), a3, voffA);
            PG8_WAIT_V(8); PG8_WAIT_L(0); PG8_BAR; PG8_MMA(1, 0, At, B0); PG8_MMA(1, 1, At, B1); PG8_BAR; PG8_SCHED;
            } else {
            PG8_LDB(B0, 0, 0); PG8_SCHED; PG8_LDA(At, 0, 0); PG8_STAGE(PG8_SA(1, 1), a1 + hstep, voffA);
            PG8_WAIT_L(8); PG8_BAR; PG8_WAIT_L(0); PG8_MMA(0, 0, At, B0); PG8_BAR; PG8_SCHED;
            PG8_LDB(B1, 0, 1); PG8_STAGE(PG8_SB(0, 0), b2, voffB);
            PG8_BAR; PG8_WAIT_L(0); PG8_MMA(0, 1, At, B1); PG8_BAR;
            PG8_LDA(At, 0, 1); PG8_STAGE(PG8_SA(0, 0), a2, voffA);
            PG8_BAR; PG8_WAIT_L(0); PG8_MMA(1, 0, At, B0); PG8_BAR; PG8_SCHED;
            PG8_STAGE(PG8_SB(0, 1), b2 + hstep, voffB);
            PG8_WAIT_V(6); PG8_BAR; PG8_MMA(1, 1, At, B1); PG8_BAR;
            PG8_LDB(B0, 1, 0); PG8_SCHED; PG8_LDA(At, 1, 0); PG8_STAGE(PG8_SA(0, 1), a2 + hstep, voffA);
            PG8_WAIT_L(8); PG8_BAR; PG8_WAIT_L(0); PG8_MMA(0, 0, At, B0); PG8_BAR; PG8_SCHED;
            PG8_LDB(B1, 1, 1); PG8_STAGE(PG8_SB(1, 0), b3, voffB);
            PG8_BAR; PG8_WAIT_L(0); PG8_MMA(0, 1, At, B1); PG8_BAR;
            PG8_LDA(At, 1, 1); PG8_STAGE(PG8_SA(1, 0), a3, voffA);
            PG8_BAR; PG8_WAIT_L(0); PG8_MMA(1, 0, At, B0); PG8_BAR; PG8_SCHED;
            PG8_STAGE(PG8_SB(1, 1), b3 + hstep, voffB);
            PG8_WAIT_V(6); PG8_BAR; PG8_MMA(1, 1, At, B1); PG8_BAR;
            }
        }
        if constexpr (ALIGN_EPI) { if (wr == 0) PG8_BAR; }
        if constexpr (!Epi::AFTER_DRAIN) { E(acc, cur, wr, wc, fr, fq); S.done(cur); }
        if (!has_next) break;
#pragma unroll
        for (int a = 0; a < 2; ++a)
#pragma unroll
            for (int b = 0; b < 2; ++b)
#pragma unroll
                for (int m = 0; m < 4; ++m)
#pragma unroll
                    for (int n = 0; n < 2; ++n) acc[a][b][m][n] = (f32x4){0.f, 0.f, 0.f, 0.f};
        cur = nxt; cA = nA; cB = nB; ++ui;
        if constexpr (ALIGN_EPI) { if (wr == 1) PG8_BAR; }
    }
    PG8_WAIT_V(0);
    if constexpr (!ALIGN_EPI) { if (wr == 0) PG8_BAR; }
    PG8_BAR;
    if constexpr (Epi::AFTER_DRAIN) { E.fused(acc, cur, wr, wc, fr, fq, lds, wid, lane); S.done(cur); }
#undef PG8_SA
#undef PG8_SB
#undef PG8_STAGE
#undef PG8_LDA
#undef PG8_LDB
#undef PG8_MMA
#undef PG8_WAIT_V
#undef PG8_WAIT_L
#undef PG8_BAR
#undef PG8_SCHED
}
}

namespace mk {
using pg8::bf16_t;
typedef short bf16x8 __attribute__((ext_vector_type(8)));
typedef short s16x4 __attribute__((ext_vector_type(4)));
typedef float f32x16 __attribute__((ext_vector_type(16)));
typedef float f32x4 __attribute__((ext_vector_type(4)));
typedef unsigned u32x4 __attribute__((ext_vector_type(4)));
#define MK_LAS __attribute__((address_space(3)))
constexpr int T = 98304, TP = 65536, D = 1024, FF = 2816, INW = 2304, SEQ = 4096;
constexpr int LDS_BYTES = 133120;
constexpr float INV0 = 1.000000000e+00f, INV1 = 1.939227447e-01f, INV2 = 3.760603093e-02f, INV3 = 7.292664737e-03f, INV4 = 1.414213562e-03f, INV5 = 2.742481757e-04f, INV6 = 5.318295897e-05f, INV7 = 1.031338538e-05f;
constexpr size_t OFF_BIG = 0;
constexpr size_t OFF_MERGED = (size_t)T * FF * 2;
constexpr size_t OFF_XB = OFF_MERGED + (size_t)T * D * 2;
constexpr size_t OFF_LSE = OFF_XB + (size_t)T * D * 2;
constexpr size_t OFF_W = OFF_LSE + (size_t)3 * T * 8 * 4;
constexpr size_t SZ_GU = (size_t)2 * FF * D * 2, SZ_DN = (size_t)D * FF * 2, SZ_IN = (size_t)INW * D * 2, SZ_OUT = (size_t)D * D * 2;
constexpr size_t OFF_GU1 = OFF_W, OFF_DN1 = OFF_GU1 + SZ_GU, OFF_GU2 = OFF_DN1 + SZ_DN, OFF_DN2 = OFF_GU2 + SZ_GU, OFF_WIN = OFF_DN2 + SZ_DN, OFF_WOUT = OFF_WIN + SZ_IN;
constexpr size_t OFF_SS = OFF_WOUT + SZ_OUT;
constexpr size_t OFF_ROPE = OFF_SS + (size_t)4 * T * 4;
constexpr size_t WS_END = OFF_ROPE + (size_t)SEQ * 16 * 4;

struct Args { const float* in[17]; float* out; unsigned char* ws; int ph_lo, ph_hi; };

__device__ __forceinline__ unsigned pk2(float lo, float hi) { return pg8::cvt_pk_bf16(lo, hi); }
__device__ __forceinline__ float wave_sum(float v) {
#pragma unroll
    for (int o = 1; o < 64; o <<= 1) v += __shfl_xor(v, o);
    return v;
}
#define MK_LDS_WAIT() asm volatile("s_waitcnt lgkmcnt(0)" ::: "memory")

__device__ __forceinline__ void p0_weight_item(const float* W0, const float* W1, int kind, int K, int Nsrc, const float* gain0, const float* gain1, bf16_t* WT, MK_LAS float* scr, int item, int nblk, int lane) {
    const int kb = item / nblk, nb = item % nblk, k0 = 64 * kb, n0 = 32 * nb;
    const int R = n0 + (lane & 31);
    const float* src; int col;
    if (kind == 0) { const int n = (R >> 2) & 1; col = 128 * (R >> 8) + 32 * ((R >> 5) & 3) + 8 * ((R >> 3) & 3) + 4 * ((R >> 7) & 1) + (R & 3); src = n ? W1 : W0; }
    else { col = R; src = W0; }
#pragma unroll
    for (int i = 0; i < 32; ++i) { const int kk = 2 * i + (lane >> 5); const int k = k0 + kk;
        float g = 1.0f; if (gain0) g = (gain1 && k >= 512) ? gain1[k - 512] : gain0[k];
        scr[kk * 33 + (lane & 31)] = src[(size_t)k * Nsrc + col] * g; }
    MK_LDS_WAIT();
    const int c = lane & 7;
#pragma unroll
    for (int j = 0; j < 4; ++j) { const int n = (lane >> 3) + 8 * j; const MK_LAS float* s = scr + (8 * c) * 33 + n;
        u32x4 o; o.x = pk2(s[0 * 33], s[1 * 33]); o.y = pk2(s[2 * 33], s[3 * 33]); o.z = pk2(s[4 * 33], s[5 * 33]); o.w = pk2(s[6 * 33], s[7 * 33]);
        *(u32x4*)(WT + (size_t)(n0 + n) * K + k0 + 8 * c) = o; }
    MK_LDS_WAIT();
}

__device__ __forceinline__ void phase_prologue(const Args& a, MK_LAS unsigned char* lds, int gw, int NGW, int wave, int lane) {
    MK_LAS float* scr = (MK_LAS float*)(lds + wave * 8448);
    unsigned char* ws = a.ws;
    constexpr int I_GU = (D / 64) * (2 * FF / 32), I_DN = (FF / 64) * (D / 32), I_IN = (D / 64) * (INW / 32), I_OUT = (D / 64) * (D / 32);
    constexpr int NITEMS = 2 * I_GU + 2 * I_DN + I_IN + I_OUT;
    for (int it = gw; it < NITEMS; it += NGW) {
        int r = it; const float *W0, *W1 = nullptr, *g0 = nullptr, *g1 = nullptr; int kind = 1, K = D, Nsrc = D; size_t woff;
        if (r < 2 * I_GU) { const bool s2 = r >= I_GU; r -= s2 ? I_GU : 0; W0 = a.in[s2 ? 13 : 3]; W1 = a.in[s2 ? 14 : 4]; g0 = a.in[s2 ? 12 : 2]; kind = 0; Nsrc = FF; woff = s2 ? OFF_GU2 : OFF_GU1; }
        else if (r < 2 * I_GU + 2 * I_DN) { r -= 2 * I_GU; const bool s2 = r >= I_DN; r -= s2 ? I_DN : 0; W0 = a.in[s2 ? 15 : 5]; K = FF; woff = s2 ? OFF_DN2 : OFF_DN1; }
        else if (r < 2 * I_GU + 2 * I_DN + I_IN) { r -= 2 * I_GU + 2 * I_DN; W0 = a.in[7]; g0 = a.in[6]; Nsrc = INW; woff = OFF_WIN; }
        else { r -= 2 * I_GU + 2 * I_DN + I_IN; W0 = a.in[11]; g0 = a.in[9]; g1 = a.in[10]; woff = OFF_WOUT; }
        const int nblk = (kind == 0 ? 2 * FF : Nsrc) / 32;
        p0_weight_item(W0, W1, kind, K, Nsrc, g0, g1, (bf16_t*)(ws + woff), scr, r, nblk, lane);
    }
    bf16_t* xb = (bf16_t*)(ws + OFF_XB); float* ss = (float*)(ws + OFF_SS);
    constexpr int RB = 4;
    for (int row0 = gw * RB; row0 < T; row0 += NGW * RB) {
        f32x4 v[RB][4];
#pragma unroll
        for (int q = 0; q < RB; ++q) { const int row = row0 + q; const float* xr = row < TP ? a.in[0] + (size_t)row * D : a.in[1] + (size_t)(row - TP) * D;
#pragma unroll
            for (int j = 0; j < 2; ++j) { v[q][2 * j] = *(const f32x4*)(xr + j * 512 + lane * 8); v[q][2 * j + 1] = *(const f32x4*)(xr + j * 512 + lane * 8 + 4); } }
#pragma unroll
        for (int q = 0; q < RB; ++q) { const int row = row0 + q; float s = 0.f;
#pragma unroll
            for (int j = 0; j < 2; ++j) { const f32x4 v0 = v[q][2 * j], v1 = v[q][2 * j + 1];
                s += (v0[0] * v0[0] + v0[1] * v0[1]) + (v0[2] * v0[2] + v0[3] * v0[3]) + (v1[0] * v1[0] + v1[1] * v1[1]) + (v1[2] * v1[2] + v1[3] * v1[3]);
                u32x4 w; w.x = pk2(v0[0], v0[1]); w.y = pk2(v0[2], v0[3]); w.z = pk2(v1[0], v1[1]); w.w = pk2(v1[2], v1[3]);
                *(u32x4*)(xb + (size_t)row * D + j * 512 + lane * 8) = w; }
            s = wave_sum(s);
            if (lane == 0) { ss[row] = s; ss[T + row] = 0.f; ss[2 * T + row] = 0.f; ss[3 * T + row] = 0.f; } }
    }
    float* rope = (float*)(ws + OFF_ROPE);
    for (int i = gw * 64 + lane; i < SEQ * 8; i += NGW * 64) {
        const int pos = i >> 3, j = i & 7;
        const float inv = j == 0 ? INV0 : j == 1 ? INV1 : j == 2 ? INV2 : j == 3 ? INV3 : j == 4 ? INV4 : j == 5 ? INV5 : j == 6 ? INV6 : INV7;
        const float ang = (float)pos * inv;
        double tr = (double)ang * 0.15915494309189535; tr -= __builtin_floor(tr);
        const float fr = (float)tr;
        rope[pos * 16 + j] = __builtin_amdgcn_cosf(fr); rope[pos * 16 + 8 + j] = __builtin_amdgcn_sinf(fr);
    }
}

__device__ __forceinline__ int crow(int r, int hi) { return (r & 3) + 8 * (r >> 2) + 4 * hi; }
typedef short v4i16_t __attribute__((ext_vector_type(4)));
__device__ __forceinline__ s16x4 vtr(const MK_LAS unsigned char* p) { return __builtin_bit_cast(s16x4, __builtin_amdgcn_ds_read_tr16_b64_v4i16((MK_LAS v4i16_t*)p)); }
#define MK_MFMA32(a, b, c) __builtin_amdgcn_mfma_f32_32x32x16_bf16(a, b, c, 0, 0, 0)
constexpr int ATT_NK = 384, ATT_KCS = (ATT_NK + 1) * 16  , ATT_VOFF = 49408, ATT_VDS = ATT_NK * 64  , ATT_WOFF = ATT_VOFF + 2 * ATT_VDS, ATT_WSZ = 4224;
static_assert(8 * ATT_KCS <= ATT_VOFF && ATT_WOFF + 8 * ATT_WSZ <= LDS_BYTES, "attention LDS map");
constexpr float ATT_THR = 8.0f;
#define MK_WAIT_BAR() asm volatile("s_waitcnt lgkmcnt(0)\n\ts_barrier" ::: "memory")

struct AttItem {
    size_t rowbase;
    int qcol, kcol, vcol;
    int stride, res, hw, L;
    int kb0, NK;
    int q0;
    int isA;
    bf16_t* out; int out_ld, out_col;
    float* lse;
};
__device__ __forceinline__ void att_decode(const Args& a, int id, AttItem& I) {
    unsigned char* ws = a.ws;
    bf16_t* merged = (bf16_t*)(ws + OFF_MERGED);
    constexpr int NA = 24 * 2 * 64;
    if (id < NA) {
        const int n = id >> 7, kvh = (id >> 6) & 1, qb = id & 63;
        I.rowbase = (size_t)n * SEQ; I.qcol = kvh * 256; I.kcol = 512 + kvh * 64; I.vcol = 640 + kvh * 64;
        I.stride = 1; I.res = 0; I.hw = 128; I.L = SEQ; I.kb0 = 64 * qb - 128; I.NK = 320; I.q0 = 64 * qb; I.isA = 1;
        I.out = merged; I.out_ld = 1024; I.out_col = kvh * 256; I.lse = nullptr;
    } else {
        const int idb = id - NA; const int n = idb / 384, rem = idb - n * 384, h = rem / 48, k = rem - h * 48, g = k >> 4, f = k & 15;
        const int sh = 2 * g, dd = 1 << sh, c = f >> sh;
        I.rowbase = (size_t)n * SEQ; I.qcol = 768 + h * 64; I.kcol = 1280 + h * 64; I.vcol = 1792 + h * 64;
        I.stride = dd; I.res = f & (dd - 1); I.hw = 64; I.L = SEQ >> sh; I.kb0 = 256 * c - 64; I.NK = 384; I.q0 = 256 * c; I.isA = 0;
        if (g == 0) { I.out = merged; I.out_ld = 1024; I.out_col = 512 + h * 64; }
        else { I.out = (bf16_t*)(ws + OFF_XB) + (size_t)(g - 1) * T * 512; I.out_ld = 512; I.out_col = h * 64; }
        I.lse = (float*)(ws + OFF_LSE) + (size_t)g * T * 8 + h;
    }
}
__device__ __forceinline__ void att_prefetch(const bf16_t* __restrict__ proj, const AttItem& I, int tid, u32x4 (&kr)[6], u32x4 (&vr)[6]) {
    const bf16_t* seq0 = proj + (I.rowbase + I.res) * INW + (tid & 7) * 8;
    const size_t tokstride = (size_t)I.stride * INW;
#pragma unroll
    for (int i = 0; i < 6; ++i) {
        const int row = i * 64 + (tid >> 3), key = I.kb0 + row;
        if (row < I.NK && key >= 0 && key < I.L) { const bf16_t* p = seq0 + (size_t)key * tokstride; kr[i] = *(const u32x4*)(p + I.kcol); vr[i] = *(const u32x4*)(p + I.vcol); }
        else { kr[i] = (u32x4){0u, 0u, 0u, 0u}; vr[i] = (u32x4){0u, 0u, 0u, 0u}; }
    }
}
__device__ __forceinline__ void att_store(MK_LAS unsigned char* lds, int tid, const u32x4 (&kr)[6], const u32x4 (&vr)[6]) {
    const int chunk = tid & 7;
    MK_LAS unsigned char* kp = lds + chunk * ATT_KCS + (tid >> 3) * 16;
    MK_LAS unsigned char* vp = lds + ATT_VOFF + (chunk >> 2) * ATT_VDS + (tid >> 3) * 64 + (chunk & 3) * 16;
#pragma unroll
    for (int i = 0; i < 6; ++i) { *(MK_LAS u32x4*)(kp + i * 64 * 16) = kr[i]; *(MK_LAS u32x4*)(vp + i * 64 * 64) = vr[i]; }
}

__device__ __forceinline__ void att_compute(const Args& a, const bf16_t* __restrict__ proj, const AttItem& I, MK_LAS unsigned char* lds, int wave, int lane) {
    const int r32 = lane & 31, hi = lane >> 5;
    MK_LAS unsigned char* wl = lds + ATT_WOFF + wave * ATT_WSZ;
    MK_LAS float* wsf = (MK_LAS float*)(wl + 4096);
    const int hsel = I.isA ? (wave & 3) : 0;
    const int t0 = I.q0 + 32 * (I.isA ? (wave >> 2) : wave);
    const int qcol = I.qcol + hsel * 64, ocol = I.out_col + hsel * 64;
    const int nkt = I.hw / 16 + 1;
    const int kt_lo = t0 >= I.hw ? 0 : ((I.hw - t0) >> 5);
    int kt_hi = (I.L - t0 + I.hw) >> 5; kt_hi = kt_hi < nkt ? kt_hi : nkt;
    const size_t tokstride = (size_t)I.stride * INW;
    const bf16_t* seq0 = proj + (I.rowbase + I.res) * INW;
    const bf16_t* qp = seq0 + (size_t)(t0 + r32) * tokstride + qcol + hi * 8;
    bf16x8 qr[4];
#pragma unroll
    for (int d0 = 0; d0 < 4; ++d0) qr[d0] = *(const bf16x8*)(qp + d0 * 16);
    float sink_l2 = 0.f; if (I.isA) sink_l2 = a.in[8][(I.qcol >> 6) + hsel] * 1.4426950408889634f;
    const MK_LAS unsigned char* kfb = lds + hi * ATT_KCS + r32 * 16;
    const MK_LAS unsigned char* vfb = lds + ATT_VOFF + ((lane >> 4) & 1) * 32 + (lane & 3) * 8 + (4 * hi + ((lane & 15) >> 2)) * 64;
    float mhat = -1.0e4f, lsum = 0.f;
    f32x16 o0 = {}, o1 = {};
    for (int kt = kt_lo; kt < kt_hi; ++kt) {
        const int krow0 = t0 - I.hw + 32 * kt - I.kb0;
        const MK_LAS unsigned char* kp = kfb + krow0 * 16;
        bf16x8 kf[4];
#pragma unroll
        for (int d0 = 0; d0 < 4; ++d0) kf[d0] = *(const MK_LAS bf16x8*)(kp + 2 * d0 * ATT_KCS);
        const MK_LAS unsigned char* vp = vfb + krow0 * 64;
#define MK_VFR(off) __builtin_shufflevector(vtr(vp + (off)), vtr(vp + (off) + 512), 0, 1, 2, 3, 4, 5, 6, 7)
        const bf16x8 v00 = MK_VFR(0), v01 = MK_VFR(ATT_VDS), v10 = MK_VFR(1024), v11 = MK_VFR(ATT_VDS + 1024);
#undef MK_VFR
        f32x16 p = {};
#pragma unroll
        for (int d0 = 0; d0 < 4; ++d0) p = MK_MFMA32(kf[d0], qr[d0], p);
        if (kt == 0) {
#pragma unroll
            for (int r = 0; r < 16; ++r) if (crow(r, hi) < r32) p[r] = -1.0e30f;
        }
        if (kt == nkt - 1) {
#pragma unroll
            for (int r = 0; r < 16; ++r) if (crow(r, hi) > r32) p[r] = -1.0e30f;
        }
        float rm = __builtin_fmaxf(p[0], p[1]);
#pragma unroll
        for (int r = 2; r < 16; ++r) rm = __builtin_fmaxf(rm, p[r]);
        rm = __builtin_fmaxf(rm, __shfl_xor(rm, 32));
        if (__any(rm > mhat + ATT_THR)) {
            const float mnew = __builtin_fmaxf(mhat, rm), f = __builtin_amdgcn_exp2f(mhat - mnew);
            lsum *= f; mhat = mnew;
            if (hi == 0) wsf[r32] = f;
            MK_LDS_WAIT();
#pragma unroll
            for (int g = 0; g < 4; ++g) { const f32x4 w4 = *(const MK_LAS f32x4*)(wsf + 8 * g + 4 * hi);
#pragma unroll
                for (int j = 0; j < 4; ++j) { o0[4 * g + j] *= w4[j]; o1[4 * g + j] *= w4[j]; } }
            MK_LDS_WAIT();
        }
        float sacc = 0.f;
#pragma unroll
        for (int r = 0; r < 16; ++r) { p[r] = __builtin_amdgcn_exp2f(p[r] - mhat); sacc += p[r]; }
        lsum += sacc;
        u32x4 pw0, pw1;
        pw0.x = pk2(p[0], p[1]); pw0.y = pk2(p[2], p[3]); pw0.z = pk2(p[4], p[5]); pw0.w = pk2(p[6], p[7]);
        pw1.x = pk2(p[8], p[9]); pw1.y = pk2(p[10], p[11]); pw1.z = pk2(p[12], p[13]); pw1.w = pk2(p[14], p[15]);
        o0 = MK_MFMA32(__builtin_bit_cast(bf16x8, pw0), v00, o0); o1 = MK_MFMA32(__builtin_bit_cast(bf16x8, pw0), v01, o1);
        o0 = MK_MFMA32(__builtin_bit_cast(bf16x8, pw1), v10, o0); o1 = MK_MFMA32(__builtin_bit_cast(bf16x8, pw1), v11, o1);
    }
    float ltot = lsum + __shfl_xor(lsum, 32);
    if (I.isA) ltot += __builtin_amdgcn_exp2f(sink_l2 - mhat);
    const float rl = 1.0f / ltot;
    if (hi == 0) wsf[r32] = rl;
    MK_LDS_WAIT();
    MK_LAS bf16_t* stg = (MK_LAS bf16_t*)wl;
#pragma unroll
    for (int g = 0; g < 4; ++g) { const f32x4 w4 = *(const MK_LAS f32x4*)(wsf + 8 * g + 4 * hi);
#pragma unroll
        for (int j = 0; j < 4; ++j) { const int r = 4 * g + j, orow = crow(r, hi);
            stg[orow * 64 + r32] = (bf16_t)(pk2(o0[r] * w4[j], 0.f) & 0xffffu); stg[orow * 64 + 32 + r32] = (bf16_t)(pk2(o1[r] * w4[j], 0.f) & 0xffffu); } }
    MK_LDS_WAIT();
#pragma unroll
    for (int i = 0; i < 4; ++i) { const int row = i * 8 + (lane >> 3), ch = lane & 7;
        *(u32x4*)(I.out + (I.rowbase + I.res + (size_t)I.stride * (t0 + row)) * I.out_ld + ocol + ch * 8) = *(const MK_LAS u32x4*)(stg + row * 64 + ch * 8); }
    if (I.lse && hi == 0) I.lse[(I.rowbase + I.res + (size_t)I.stride * (t0 + r32)) * 8] = mhat + __builtin_log2f(ltot);
}

__device__ __forceinline__ void phase_attention(const Args& a, MK_LAS unsigned char* lds, int vcu, int G, int tid, int wave, int lane) {
    const bf16_t* proj = (const bf16_t*)(a.ws + OFF_BIG);
    constexpr int NITEMS = 24 * 2 * 64 + 24 * 8 * 48;
    u32x4 kr[6], vr[6];
    int id = vcu;
    AttItem I;
    if (id < NITEMS) { att_decode(a, id, I); att_prefetch(proj, I, tid, kr, vr); }
    while (id < NITEMS) {
        att_store(lds, tid, kr, vr);
        MK_WAIT_BAR();
        const int nid = id + G;
        if (nid < NITEMS) { AttItem N; att_decode(a, nid, N); att_prefetch(proj, N, tid, kr, vr); }
        att_compute(a, proj, I, lds, wave, lane);
        MK_WAIT_BAR();
        id = nid;
        if (id < NITEMS) att_decode(a, id, I);
    }
}

__device__ __forceinline__ void unpack8(const u32x4 w, float (&v)[8]) {
    v[0] = __uint_as_float(w.x << 16); v[1] = __uint_as_float(w.x & 0xffff0000u); v[2] = __uint_as_float(w.y << 16); v[3] = __uint_as_float(w.y & 0xffff0000u);
    v[4] = __uint_as_float(w.z << 16); v[5] = __uint_as_float(w.z & 0xffff0000u); v[6] = __uint_as_float(w.w << 16); v[7] = __uint_as_float(w.w & 0xffff0000u);
}
__device__ __forceinline__ u32x4 pack8(const float (&v)[8], float s) { u32x4 w; w.x = pk2(v[0] * s, v[1] * s); w.y = pk2(v[2] * s, v[3] * s); w.z = pk2(v[4] * s, v[5] * s); w.w = pk2(v[6] * s, v[7] * s); return w; }
__device__ __forceinline__ void phase_finalize(const Args& a, int gw, int NGW, int lane) {
    unsigned char* ws = a.ws;
    bf16_t* merged = (bf16_t*)(ws + OFF_MERGED); const bf16_t* ob2 = (const bf16_t*)(ws + OFF_XB); const bf16_t* ob3 = ob2 + (size_t)T * 512; const float* lse = (const float*)(ws + OFF_LSE);
    const int h = lane >> 3;
    constexpr int RB = 4;
    for (int row0 = gw * RB; row0 < T; row0 += NGW * RB) {
        u32x4 wa[RB], w1[RB], w2[RB], w3[RB]; float l1[RB], l2[RB], l3[RB];
#pragma unroll
        for (int q = 0; q < RB; ++q) { const size_t row = row0 + q; const bf16_t* mr = merged + row * 1024;
            wa[q] = *(const u32x4*)(mr + lane * 8); w1[q] = *(const u32x4*)(mr + 512 + lane * 8);
            w2[q] = *(const u32x4*)(ob2 + row * 512 + lane * 8); w3[q] = *(const u32x4*)(ob3 + row * 512 + lane * 8);
            l1[q] = lse[row * 8 + h]; l2[q] = lse[(size_t)T * 8 + row * 8 + h]; l3[q] = lse[(size_t)2 * T * 8 + row * 8 + h]; }
#pragma unroll
        for (int q = 0; q < RB; ++q) { bf16_t* mr = merged + (size_t)(row0 + q) * 1024;
            float va[8], b1[8], b2[8], b3[8];
            unpack8(wa[q], va); unpack8(w1[q], b1); unpack8(w2[q], b2); unpack8(w3[q], b3);
            const float mx = __builtin_fmaxf(l1[q], __builtin_fmaxf(l2[q], l3[q]));
            const float e1 = __builtin_amdgcn_exp2f(l1[q] - mx), e2 = __builtin_amdgcn_exp2f(l2[q] - mx), e3 = __builtin_amdgcn_exp2f(l3[q] - mx), ri = 1.0f / (e1 + e2 + e3);
            const float c1 = e1 * ri, c2 = e2 * ri, c3 = e3 * ri;
            float sa = 0.f, sb = 0.f;
#pragma unroll
            for (int j = 0; j < 8; ++j) { b1[j] = c1 * b1[j] + c2 * b2[j] + c3 * b3[j]; sa += va[j] * va[j]; sb += b1[j] * b1[j]; }
            sa = wave_sum(sa); sb = wave_sum(sb);
            const float ra = __builtin_amdgcn_rsqf(sa * (1.0f / 512.0f) + 1e-6f), rb = __builtin_amdgcn_rsqf(sb * (1.0f / 512.0f) + 1e-6f);
            *(u32x4*)(mr + lane * 8) = pack8(va, ra);
            *(u32x4*)(mr + 512 + lane * 8) = pack8(b1, rb); }
    }
}

__device__ __forceinline__ void phase_final_norm(const Args& a, int gw, int NGW, int lane) {
    const float* ss = (const float*)(a.ws + OFF_SS) + (size_t)3 * T; const float* gain = a.in[16];
    f32x4 g[4];
#pragma unroll
    for (int j = 0; j < 4; ++j) g[j] = *(const f32x4*)(gain + j * 256 + lane * 4);
    constexpr int RB = 4;
    for (int row0 = gw * RB; row0 < T; row0 += NGW * RB) {
        f32x4 v[RB][4]; float rs[RB];
#pragma unroll
        for (int q = 0; q < RB; ++q) { const float* xr = a.out + (size_t)(row0 + q) * D; rs[q] = ss[row0 + q];
#pragma unroll
            for (int j = 0; j < 4; ++j) v[q][j] = *(const f32x4*)(xr + j * 256 + lane * 4); }
#pragma unroll
        for (int q = 0; q < RB; ++q) { float* xr = a.out + (size_t)(row0 + q) * D; const float r = pg8::rstd_of(rs[q]);
#pragma unroll
            for (int j = 0; j < 4; ++j) *(f32x4*)(xr + j * 256 + lane * 4) = v[q][j] * r * g[j]; }
    }
}

constexpr int NPHASE = 10;
#ifndef MK_MASK
#define MK_MASK 0x3ff
#endif
#define MK_ON(p) ((MK_MASK >> (p)) & 1)
__global__ __launch_bounds__(512) void mk_fwd(const Args a) {
    extern __shared__ __attribute__((aligned(16))) unsigned char lds_raw[];
    MK_LAS unsigned char* lds = (MK_LAS unsigned char*)lds_raw;
    cg::grid_group grid = cg::this_grid();
#ifndef MK_REP
#define MK_REP 0
#endif
    for (int ph2 = a.ph_lo * 2; ph2 < a.ph_hi * 2; ++ph2) {
        const int ph = ph2 >> 1;
        if ((ph2 & 1) && !((MK_REP >> ph) & 1)) continue;
        if (ph2 > a.ph_lo * 2) grid.sync();
        int tid = threadIdx.x; asm volatile("" : "+v"(tid));
        const int lane = tid & 63, wave = __builtin_amdgcn_readfirstlane(tid >> 6);
        int G = gridDim.x, bid = blockIdx.x; asm volatile("" : "+s"(G), "+s"(bid));
        const int vcu = (bid & 7) * (G >> 3) + (bid >> 3);
        const int gw = vcu * 8 + wave, NGW = G * 8;
        unsigned char* ws = a.ws; asm volatile("" : "+s"(ws));
        float* ss = (float*)(ws + OFF_SS);
        if (MK_ON(0) && ph == 0) phase_prologue(a, lds, gw, NGW, wave, lane);
        else if (MK_ON(1) && (ph == 1 || ph == 7)) {
            const bool second = ph == 7;
            pg8::Gemm g; g.A = (const bf16_t*)(ws + OFF_XB); g.Bt = (const bf16_t*)(ws + (second ? OFF_GU2 : OFF_GU1)); g.M = T; g.N = 2 * FF; g.K = D;
            pg8::StaticOrder S; S.init(T, 2 * FF, G, bid);
            pg8::EpiGateUp E; E.H = (bf16_t*)(ws + OFF_BIG); E.ss = ss + (second ? 2 * (size_t)T : 0);
            pg8::gemm_phase<pg8::EpiGateUp, pg8::StaticOrder, true, true>(lds, g, S, E, tid);
        } else if (MK_ON(2) && (ph == 2 || ph == 6 || ph == 8)) {
            pg8::Gemm g; pg8::EpiResid E; E.out = a.out; E.split = TP;
            if (ph == 2) { g.A = (const bf16_t*)(ws + OFF_BIG); g.Bt = (const bf16_t*)(ws + OFF_DN1); g.K = FF; E.res_lo = a.in[0]; E.res_hi = a.in[1]; E.xb = (bf16_t*)(ws + OFF_XB); E.ssout = ss + T; E.alpha = 0.5f; }
            else if (ph == 6) { g.A = (const bf16_t*)(ws + OFF_MERGED); g.Bt = (const bf16_t*)(ws + OFF_WOUT); g.K = D; E.res_lo = a.out; E.res_hi = a.out + (size_t)TP * D; E.xb = (bf16_t*)(ws + OFF_XB); E.ssout = ss + 2 * (size_t)T; E.alpha = 1.0f; }
            else { g.A = (const bf16_t*)(ws + OFF_BIG); g.Bt = (const bf16_t*)(ws + OFF_DN2); g.K = FF; E.res_lo = a.out; E.res_hi = a.out + (size_t)TP * D; E.xb = nullptr; E.ssout = ss + 3 * (size_t)T; E.alpha = 0.5f; }
            g.M = T; g.N = D;
            pg8::StaticOrder S; S.init(T, D, G, bid);
            pg8::gemm_phase<pg8::EpiResid, pg8::StaticOrder, true, true>(lds, g, S, E, tid);
        } else if (MK_ON(3) && ph == 3) {
            pg8::Gemm g; g.A = (const bf16_t*)(ws + OFF_XB); g.Bt = (const bf16_t*)(ws + OFF_WIN); g.M = T; g.N = INW; g.K = D;
            pg8::StaticOrder S; S.init(T, INW, G, bid);
            pg8::EpiQkv E; E.P = (bf16_t*)(ws + OFF_BIG); E.ss = ss + T; E.rope = (const float*)(ws + OFF_ROPE);
            pg8::gemm_phase<pg8::EpiQkv, pg8::StaticOrder, true, true>(lds, g, S, E, tid);
        } else if (MK_ON(4) && ph == 4) phase_attention(a, lds, vcu, G, tid, wave, lane);
        else if (MK_ON(5) && ph == 5) phase_finalize(a, gw, NGW, lane);
        else if (MK_ON(9) && ph == 9) phase_final_norm(a, gw, NGW, lane);
    }
}
}

#ifndef MK_N_LAUNCHES
#define MK_N_LAUNCHES 1
#endif
extern "C" void kernel_launch(void* const* d_in, const int* in_sizes, int n_in, void* d_out, int out_size, void* d_ws, size_t ws_size, hipStream_t stream) {
    static int grid = 0;
    if (grid == 0) {
        if (n_in != 17 || out_size != mk::T * mk::D || ws_size < mk::WS_END) { fprintf(stderr, "kernel_launch: unexpected shapes (n_in %d out %d ws %zu need %zu)\n", n_in, out_size, ws_size, (size_t)mk::WS_END); grid = -1; return; }
        int dev = 0, cus = 0, per_cu = 0;
        hipGetDevice(&dev); hipDeviceGetAttribute(&cus, hipDeviceAttributeMultiprocessorCount, dev);
        if (hipFuncSetAttribute((const void*)mk::mk_fwd, hipFuncAttributeMaxDynamicSharedMemorySize, mk::LDS_BYTES) != hipSuccess) { fprintf(stderr, "kernel_launch: hipFuncSetAttribute failed\n"); grid = -1; return; }
        if (hipOccupancyMaxActiveBlocksPerMultiprocessor(&per_cu, (const void*)mk::mk_fwd, 512, mk::LDS_BYTES) != hipSuccess || per_cu < 1) { fprintf(stderr, "kernel_launch: occupancy query says %d\n", per_cu); per_cu = 1; }
        (void)hipGetLastError();
        grid = cus * 1;
        if (grid % 8) grid -= grid % 8;
    }
    if (grid < 0) return;
    mk::Args a{};
    for (int i = 0; i < 17; ++i) a.in[i] = (const float*)d_in[i];
    a.out = (float*)d_out; a.ws = (unsigned char*)d_ws;
#if MK_N_LAUNCHES == 1
    a.ph_lo = 0; a.ph_hi = 10;
    void* args[] = {(void*)&a};
    hipError_t e = hipLaunchCooperativeKernel((const void*)mk::mk_fwd, dim3(grid), dim3(512), args, mk::LDS_BYTES, stream);
    if (e != hipSuccess) fprintf(stderr, "kernel_launch: cooperative launch failed: %s (grid %d)\n", hipGetErrorString(e), grid);
#else
    for (int p = 0; p < 10; ++p) { a.ph_lo = p; a.ph_hi = p + 1; hipLaunchKernelGGL(mk::mk_fwd, dim3(grid), dim3(512), mk::LDS_BYTES, stream, a); }
#endif
}
```

```cpp
#include <hip/hip_runtime.h>
#include <hip/hip_cooperative_groups.h>
#include <cstdio>
#include <cstdint>
namespace cg = cooperative_groups;
namespace pg8 {
#define PG8_LAS __attribute__((address_space(3)))
typedef unsigned short bf16_t;
typedef short bf16x8 __attribute__((ext_vector_type(8)));
typedef float f32x4 __attribute__((ext_vector_type(4)));
typedef unsigned u32x4 __attribute__((ext_vector_type(4)));
constexpr int BM = 256, BK = 64, HALF = 128, HTB = HALF * BK * 2  , STAGE_BYTES = 8 * HTB, NXCD = 8, WGM = 8;

__host__ __device__ __forceinline__ int lds_byte(int r, int c) { const int st = (r >> 4) * 2 + (c >> 5), rr = r & 15, cc = c & 31, ob = rr * 64 + cc * 2; return st * 1024 + (ob ^ (((ob >> 9) & 1) << 5)); }
__host__ __device__ __forceinline__ void stage_rc(int b, int& R, int& C) { const int st = b / 1024, sb = b % 1024, swz = sb ^ (((sb >> 9) & 1) << 5); R = (st >> 1) * 16 + swz / 64; C = (st & 1) * 32 + (swz % 64) / 2; }
__host__ __device__ __forceinline__ int perm32(int rho) { const int n = rho >> 4, i = rho & 15; return 8 * (i >> 2) + 4 * n + (i & 3); }

struct Unit { int pm, pn; };
struct Gemm { const bf16_t* A; const bf16_t* Bt; int M, N, K; };

struct StaticOrder {
    int nM, nN, nwg, G, c;
    __host__ __device__ void init(int M, int N, int G_, int c_) { nM = M / BM; nN = N / BM; nwg = nM * nN; G = G_; c = c_; }
    __host__ __device__ bool next(int i, Unit& u) const {
        const long L = (long)i * G + c; if (L >= nwg) return false;
        int wgid = (int)L; { const int q = nwg / NXCD, r = nwg % NXCD, xcd = wgid % NXCD, off = wgid / NXCD; wgid = (xcd < r ? xcd * (q + 1) : r * (q + 1) + (xcd - r) * q) + off; }
        const int nig = WGM * nN, gid = wgid / nig, fm = gid * WGM, gsz = (nM - fm) < WGM ? (nM - fm) : WGM;
        u.pm = fm + ((wgid % nig) % gsz); u.pn = (wgid % nig) / gsz; return true;
    }
    __device__ __forceinline__ void a_ready(const Unit&) const {}
    __device__ __forceinline__ void done(const Unit&) const {}
};
__device__ __forceinline__ unsigned cvt_pk_bf16(float lo, float hi) { unsigned r; asm volatile("v_cvt_pk_bf16_f32 %0, %1, %2" : "=v"(r) : "v"(lo), "v"(hi)); return r; }

__device__ __forceinline__ float silu_f(float x) { return x * __builtin_amdgcn_rcpf(1.0f + __builtin_amdgcn_exp2f(-1.4426950408889634f * x)); }
__device__ __forceinline__ float rstd_of(float ss) { return __builtin_amdgcn_rsqf(ss * (1.0f / 1024.0f) + 1e-6f); }

struct EpiGateUp {
    static constexpr bool PERM = true, AFTER_DRAIN = false;
    bf16_t* H; const float* ss; int enabled;
    __device__ __forceinline__ void operator()(const f32x4 (&acc)[2][2][4][2], const Unit& u, int wr, int wc, int fr, int fq) const {
        if (!enabled) return;
        const int row0 = u.pm * BM + wr * 64 + fr, hcol = u.pn * 128 + wc * 32 + fq * 8;
        float ssv[2][4];
#pragma unroll
        for (int ai = 0; ai < 2; ++ai)
#pragma unroll
            for (int m = 0; m < 4; ++m) ssv[ai][m] = ss[row0 + ai * HALF + m * 16];
#pragma unroll
        for (int ai = 0; ai < 2; ++ai)
#pragma unroll
            for (int m = 0; m < 4; ++m) {
                const int row = row0 + ai * HALF + m * 16; const float rs = rstd_of(ssv[ai][m]);
                const f32x4 g0 = acc[ai][0][m][0] * rs, g1 = acc[ai][1][m][0] * rs, u0 = acc[ai][0][m][1] * rs, u1 = acc[ai][1][m][1] * rs;
                u32x4 w;
                w.x = cvt_pk_bf16(silu_f(g0[0]) * u0[0], silu_f(g0[1]) * u0[1]); w.y = cvt_pk_bf16(silu_f(g0[2]) * u0[2], silu_f(g0[3]) * u0[3]);
                w.z = cvt_pk_bf16(silu_f(g1[0]) * u1[0], silu_f(g1[1]) * u1[1]); w.w = cvt_pk_bf16(silu_f(g1[2]) * u1[2], silu_f(g1[3]) * u1[3]);
                *(u32x4*)(H + (size_t)row * 2816 + hcol) = w;
                asm volatile("" ::: "memory");
            }
    }
};

struct EpiResid {
    static constexpr bool PERM = true, AFTER_DRAIN = false;
    const float* res_lo; const float* res_hi; int split;
    float* out; bf16_t* xb; float* ssout; float alpha; int res_bf16, write_xb;
    __device__ __forceinline__ void operator()(const f32x4 (&acc)[2][2][4][2], const Unit& u, int wr, int wc, int fr, int fq) const {
        const int row0 = u.pm * BM + wr * 64 + fr, col0 = u.pn * BM + wc * 32 + fq * 8;
        const float* rbase = (u.pm * BM < split) ? res_lo : res_hi - (size_t)split * 1024;
        auto row_out = [&](const int ai, const int m, const f32x4 (&r0)[2], const f32x4 (&r1)[2]) {
            const int row = row0 + ai * HALF + m * 16; float s = 0.f;
#pragma unroll
            for (int bj = 0; bj < 2; ++bj) {
                const size_t off = (size_t)row * 1024 + col0 + bj * HALF;
                const f32x4 v0 = r0[bj] + alpha * acc[ai][bj][m][0], v1 = r1[bj] + alpha * acc[ai][bj][m][1];
                if (out) { *(f32x4*)(out + off) = v0; *(f32x4*)(out + off + 4) = v1; }
                if (write_xb) { u32x4 w; w.x = cvt_pk_bf16(v0[0], v0[1]); w.y = cvt_pk_bf16(v0[2], v0[3]); w.z = cvt_pk_bf16(v1[0], v1[1]); w.w = cvt_pk_bf16(v1[2], v1[3]); *(u32x4*)(xb + off) = w; }
                s += (v0[0] * v0[0] + v0[1] * v0[1]) + (v0[2] * v0[2] + v0[3] * v0[3]) + (v1[0] * v1[0] + v1[1] * v1[1]) + (v1[2] * v1[2] + v1[3] * v1[3]);
            }
            s += __shfl_xor(s, 16); s += __shfl_xor(s, 32);
            if (fq == 0) atomicAdd(ssout + row, s);
        };
        if (res_bf16) {
#pragma unroll
            for (int ai = 0; ai < 2; ++ai) {
                u32x4 rb[4][2];
#pragma unroll
                for (int m = 0; m < 4; ++m)
#pragma unroll
                    for (int bj = 0; bj < 2; ++bj) rb[m][bj] = *(const u32x4*)(xb + (size_t)(row0 + ai * HALF + m * 16) * 1024 + col0 + bj * HALF);
#pragma unroll
                for (int m = 0; m < 4; ++m) { f32x4 r0[2], r1[2];
#pragma unroll
                    for (int bj = 0; bj < 2; ++bj) { const u32x4 w = rb[m][bj];
                        r0[bj] = (f32x4){__uint_as_float(w.x << 16), __uint_as_float(w.x & 0xffff0000u), __uint_as_float(w.y << 16), __uint_as_float(w.y & 0xffff0000u)};
                        r1[bj] = (f32x4){__uint_as_float(w.z << 16), __uint_as_float(w.z & 0xffff0000u), __uint_as_float(w.w << 16), __uint_as_float(w.w & 0xffff0000u)}; }
                    row_out(ai, m, r0, r1); }
                asm volatile("" ::: "memory");
            }
        } else {
#pragma unroll
            for (int ai = 0; ai < 2; ++ai)
#pragma unroll
                for (int mh = 0; mh < 2; ++mh) {
                    f32x4 rr[2][2][2];
#pragma unroll
                    for (int m = 0; m < 2; ++m)
#pragma unroll
                        for (int bj = 0; bj < 2; ++bj) { const size_t off = (size_t)(row0 + ai * HALF + (2 * mh + m) * 16) * 1024 + col0 + bj * HALF;
                            rr[m][bj][0] = *(const f32x4*)(rbase + off); rr[m][bj][1] = *(const f32x4*)(rbase + off + 4); }
#pragma unroll
                    for (int m = 0; m < 2; ++m) { const f32x4 r0[2] = {rr[m][0][0], rr[m][1][0]}, r1[2] = {rr[m][0][1], rr[m][1][1]}; row_out(ai, 2 * mh + m, r0, r1); }
                    asm volatile("" ::: "memory");
                }
        }
    }
};

struct EpiQkv {
    static constexpr bool PERM = true, AFTER_DRAIN = false;
    bf16_t* P; const float* ss; const float* rope;
    __device__ __forceinline__ void operator()(const f32x4 (&acc)[2][2][4][2], const Unit& u, int wr, int wc, int fr, int fq) const {
        const int row0 = u.pm * BM + wr * 64 + fr, col0 = u.pn * BM + wc * 32 + fq * 8; const int pn = u.pn;
        const bool isq = (pn <= 1) || (pn == 3) || (pn == 4);
        const float qs = isq ? 0.125f * 1.4426950408889634f : 1.0f;
        float ssv[2][4];
#pragma unroll
        for (int ai = 0; ai < 2; ++ai)
#pragma unroll
            for (int m = 0; m < 4; ++m) ssv[ai][m] = ss[row0 + ai * HALF + m * 16];
        const bool rot0 = (pn <= 6) && ((wc & 1) == 0), rot1 = rot0 && (pn != 2);
        const float sg = fq == 0 ? -1.0f : 1.0f; const bool act = fq < 2;
#pragma unroll
        for (int ai = 0; ai < 2; ++ai) {
            f32x4 cs[4][4];
            if (rot0) {
#pragma unroll
                for (int m = 0; m < 4; ++m) { const float* rp = rope + (size_t)((row0 + ai * HALF + m * 16) & 4095) * 16;
#pragma unroll
                    for (int j = 0; j < 4; ++j) cs[m][j] = *(const f32x4*)(rp + 4 * j); }
            }
#pragma unroll
            for (int m = 0; m < 4; ++m) {
                const int row = row0 + ai * HALF + m * 16; const float rs = rstd_of(ssv[ai][m]) * qs;
#pragma unroll
                for (int bj = 0; bj < 2; ++bj) {
                    f32x4 v0 = acc[ai][bj][m][0] * rs, v1 = acc[ai][bj][m][1] * rs;
                    if (bj == 0 ? rot0 : rot1) {
                        f32x4 o0, o1;
#pragma unroll
                        for (int j = 0; j < 4; ++j) { o0[j] = __shfl_xor(v0[j], 16); o1[j] = __shfl_xor(v1[j], 16); }
                        if (act) { v0 = v0 * cs[m][0] + sg * (o0 * cs[m][2]); v1 = v1 * cs[m][1] + sg * (o1 * cs[m][3]); }
                    }
                    u32x4 w; w.x = cvt_pk_bf16(v0[0], v0[1]); w.y = cvt_pk_bf16(v0[2], v0[3]); w.z = cvt_pk_bf16(v1[0], v1[1]); w.w = cvt_pk_bf16(v1[2], v1[3]);
                    *(u32x4*)(P + (size_t)row * 2304 + col0 + bj * HALF) = w;
                }
            }
            asm volatile("" ::: "memory");
        }
    }
};
template <class Epi, class Sched, bool ALIGN_EPI = false, bool SP2 = false>
__device__ __forceinline__ void gemm_phase(PG8_LAS unsigned char* lds, const Gemm g, const Sched& S, const Epi& E, const int tid) {
    const int  wid = __builtin_amdgcn_readfirstlane(tid >> 6), lane = tid & 63, wr = wid >> 2, wc = wid & 3, fr = lane & 15, fq = lane >> 4;
    const int K = g.K, nt = K / BK;
    unsigned voffA[2], voffB[2];
#pragma unroll
    for (int i = 0; i < 2; ++i) { int R, C; stage_rc(tid * 16 + i * 8192, R, C); const int Rb = Epi::PERM ? ((R & ~31) + perm32(R & 31)) : R;
        voffA[i] = (unsigned)(R * K + C) * 2u; voffB[i] = (unsigned)(Rb * K + C) * 2u; }
    const size_t kstep = (size_t)(BK * 2);
    const size_t hstep = (size_t)HALF * K * 2;
    const size_t tstep = 2 * hstep;
    const unsigned ldsw = (unsigned)wid * 1024u;
    const int aoff = lds_byte(wr * 64 + fr, fq * 8), boff = lds_byte(wc * 32 + fr, fq * 8);
#define PG8_SA(b, h) (((b) * 2 + (h)) * HTB)
#define PG8_SB(b, h) ((4 + (b) * 2 + (h)) * HTB)
#define PG8_STAGE(bufoff, gbase, voff) do { _Pragma("unroll") for (int _i = 0; _i < 2; ++_i) \
        __builtin_amdgcn_global_load_lds((const unsigned*)((const char*)(gbase) + (voff)[_i]), (PG8_LAS unsigned*)(lds + (bufoff) + ldsw + _i * 8192), 16, 0, 0); } while (0)
#define PG8_LDA(dst, b, h) do { _Pragma("unroll") for (int m = 0; m < 4; ++m) _Pragma("unroll") for (int k = 0; k < 2; ++k) dst[m][k] = *(const PG8_LAS bf16x8*)(lds + PG8_SA(b, h) + aoff + m * 2048 + k * 1024); } while (0)
#define PG8_LDB(dst, b, h) do { _Pragma("unroll") for (int n = 0; n < 2; ++n) _Pragma("unroll") for (int k = 0; k < 2; ++k) dst[n][k] = *(const PG8_LAS bf16x8*)(lds + PG8_SB(b, h) + boff + n * 2048 + k * 1024); } while (0)
#define PG8_MMA(ai, bj, At, Bt) do { __builtin_amdgcn_s_setprio(1); _Pragma("unroll") for (int m = 0; m < 4; ++m) _Pragma("unroll") for (int n = 0; n < 2; ++n) _Pragma("unroll") for (int k = 0; k < 2; ++k) \
        acc[ai][bj][m][n] = __builtin_amdgcn_mfma_f32_16x16x32_bf16(Bt[n][k], At[m][k], acc[ai][bj][m][n], 0, 0, 0); __builtin_amdgcn_s_setprio(0); } while (0)
#define PG8_WAIT_V(n) asm volatile("s_waitcnt vmcnt(" #n ")" ::: "memory")
#define PG8_WAIT_L(n) asm volatile("s_waitcnt lgkmcnt(" #n ")" ::: "memory")
#define PG8_BAR __builtin_amdgcn_s_barrier()
#define PG8_SCHED __builtin_amdgcn_sched_barrier(0)
    Unit cur, nxt; int ui = 0;
    if (!S.next(0, cur)) return;
    f32x4 acc[2][2][4][2];
#pragma unroll
    for (int a = 0; a < 2; ++a)
#pragma unroll
        for (int b = 0; b < 2; ++b)
#pragma unroll
            for (int m = 0; m < 4; ++m)
#pragma unroll
                for (int n = 0; n < 2; ++n) acc[a][b][m][n] = (f32x4){0.f, 0.f, 0.f, 0.f};
    bf16x8 At[4][2], B0[2][2], B1[2][2];
    const char* cA = (const char*)g.A + (size_t)cur.pm * tstep; const char* cB = (const char*)g.Bt + (size_t)cur.pn * tstep;
    S.a_ready(cur);
    if constexpr (SP2) {
        PG8_STAGE(PG8_SB(0, 0), cB, voffB); PG8_STAGE(PG8_SB(0, 1), cB + hstep, voffB); PG8_STAGE(PG8_SA(0, 0), cA, voffA); PG8_STAGE(PG8_SA(0, 1), cA + hstep, voffA);
        if (wr == 1) PG8_BAR;
        PG8_WAIT_V(2); PG8_BAR;
        PG8_STAGE(PG8_SB(1, 0), cB + kstep, voffB); PG8_STAGE(PG8_SA(1, 0), cA + kstep, voffA); PG8_STAGE(PG8_SB(1, 1), cB + hstep + kstep, voffB);
        PG8_WAIT_V(6); PG8_BAR;
    } else {
        PG8_STAGE(PG8_SB(0, 0), cB, voffB); PG8_STAGE(PG8_SA(0, 0), cA, voffA); PG8_STAGE(PG8_SB(0, 1), cB + hstep, voffB); PG8_STAGE(PG8_SA(0, 1), cA + hstep, voffA);
        if (wr == 1) PG8_BAR;
        PG8_WAIT_V(4); PG8_BAR;
        PG8_STAGE(PG8_SB(1, 0), cB + kstep, voffB); PG8_STAGE(PG8_SA(1, 0), cA + kstep, voffA); PG8_STAGE(PG8_SB(1, 1), cB + hstep + kstep, voffB);
        PG8_WAIT_V(6); PG8_BAR;
    }
    for (;;) {
        const bool has_next = S.next(ui + 1, nxt);
        const char* nA = has_next ? (const char*)g.A + (size_t)nxt.pm * tstep : cA; const char* nB = has_next ? (const char*)g.Bt + (size_t)nxt.pn * tstep : cB;
        for (int t = 0; t < nt; t += 2) {
            const bool last = (t == nt - 2);
            const char* a1 = cA + (size_t)(t + 1) * kstep;
            const char* a2 = last ? nA : cA + (size_t)(t + 2) * kstep; const char* b2 = last ? nB : cB + (size_t)(t + 2) * kstep;
            const char* a3 = a2 + kstep; const char* b3 = b2 + kstep;
            if (last && has_next) S.a_ready(nxt);
            if constexpr (SP2) {
            PG8_LDB(B0, 0, 0); PG8_LDB(B1, 0, 1); PG8_SCHED; PG8_LDA(At, 0, 0); PG8_STAGE(PG8_SA(1, 1), a1 + hstep, voffA);
            PG8_WAIT_V(8); PG8_WAIT_L(0); PG8_BAR; PG8_MMA(0, 0, At, B0); PG8_MMA(0, 1, At, B1); PG8_BAR; PG8_SCHED;
            PG8_LDA(At, 0, 1); PG8_STAGE(PG8_SB(0, 0), b2, voffB); PG8_STAGE(PG8_SB(0, 1), b2 + hstep, voffB); PG8_STAGE(PG8_SA(0, 0), a2, voffA);
            PG8_WAIT_V(8); PG8_WAIT_L(0); PG8_BAR; PG8_MMA(1, 0, At, B0); PG8_MMA(1, 1, At, B1); PG8_BAR; PG8_SCHED;
            PG8_LDB(B0, 1, 0); PG8_LDB(B1, 1, 1); PG8_SCHED; PG8_LDA(At, 1, 0); PG8_STAGE(PG8_SA(0, 1), a2 + hstep, voffA);
            PG8_WAIT_V(8); PG8_WAIT_L(0); PG8_BAR; PG8_MMA(0, 0, At, B0); PG8_MMA(0, 1, At, B1); PG8_BAR; PG8_SCHED;
            PG8_LDA(At, 1, 1); PG8_STAGE(PG8_SB(1, 0), b3, voffB); PG8_STAGE(PG8_SB(1, 1), b3 + hstep, voffB); PG8_STAGE(PG8_SA(1, 0), a3, voffA);
            PG8_WAIT_V(8); PG8_WAIT_L(0); PG8_BAR; PG8_MMA(1, 0, At, B0); PG8_MMA(1, 1, At, B1); PG8_BAR; PG8_SCHED;
            } else {
            PG8_LDB(B0, 0, 0); PG8_SCHED; PG8_LDA(At, 0, 0); PG8_STAGE(PG8_SA(1, 1), a1 + hstep, voffA);
            PG8_WAIT_L(8); PG8_BAR; PG8_WAIT_L(0); PG8_MMA(0, 0, At, B0); PG8_BAR; PG8_SCHED;
            PG8_LDB(B1, 0, 1); PG8_STAGE(PG8_SB(0, 0), b2, voffB);
            PG8_BAR; PG8_WAIT_L(0); PG8_MMA(0, 1, At, B1); PG8_BAR;
            PG8_LDA(At, 0, 1); PG8_STAGE(PG8_SA(0, 0), a2, voffA);
            PG8_BAR; PG8_WAIT_L(0); PG8_MMA(1, 0, At, B0); PG8_BAR; PG8_SCHED;
            PG8_STAGE(PG8_SB(0, 1), b2 + hstep, voffB);
            PG8_WAIT_V(6); PG8_BAR; PG8_MMA(1, 1, At, B1); PG8_BAR;
            PG8_LDB(B0, 1, 0); PG8_SCHED; PG8_LDA(At, 1, 0); PG8_STAGE(PG8_SA(0, 1), a2 + hstep, voffA);
            PG8_WAIT_L(8); PG8_BAR; PG8_WAIT_L(0); PG8_MMA(0, 0, At, B0); PG8_BAR; PG8_SCHED;
            PG8_LDB(B1, 1, 1); PG8_STAGE(PG8_SB(1, 0), b3, voffB);
            PG8_BAR; PG8_WAIT_L(0); PG8_MMA(0, 1, At, B1); PG8_BAR;
            PG8_LDA(At, 1, 1); PG8_STAGE(PG8_SA(1, 0), a3, voffA);
            PG8_BAR; PG8_WAIT_L(0); PG8_MMA(1, 0, At, B0); PG8_BAR; PG8_SCHED;
            PG8_STAGE(PG8_SB(1, 1), b3 + hstep, voffB);
            PG8_WAIT_V(6); PG8_BAR; PG8_MMA(1, 1, At, B1); PG8_BAR;
            }
        }
        if constexpr (ALIGN_EPI) { if (wr == 0) PG8_BAR; }
        if constexpr (!Epi::AFTER_DRAIN) { E(acc, cur, wr, wc, fr, fq); S.done(cur); }
        if (!has_next) break;
#pragma unroll
        for (int a = 0; a < 2; ++a)
#pragma unroll
            for (int b = 0; b < 2; ++b)
#pragma unroll
                for (int m = 0; m < 4; ++m)
#pragma unroll
                    for (int n = 0; n < 2; ++n) acc[a][b][m][n] = (f32x4){0.f, 0.f, 0.f, 0.f};
        cur = nxt; cA = nA; cB = nB; ++ui;
        if constexpr (ALIGN_EPI) { if (wr == 1) PG8_BAR; }
    }
    PG8_WAIT_V(0);
    if constexpr (!ALIGN_EPI) { if (wr == 0) PG8_BAR; }
    PG8_BAR;
    if constexpr (Epi::AFTER_DRAIN) { E.fused(acc, cur, wr, wc, fr, fq, lds, wid, lane); S.done(cur); }
#undef PG8_SA
#undef PG8_SB
#undef PG8_STAGE
#undef PG8_LDA
#undef PG8_LDB
#undef PG8_MMA
#undef PG8_WAIT_V
#undef PG8_WAIT_L
#undef PG8_BAR
#undef PG8_SCHED
}
}

namespace mk {
using pg8::bf16_t;
typedef short bf16x8 __attribute__((ext_vector_type(8)));
typedef short s16x4 __attribute__((ext_vector_type(4)));
typedef float f32x16 __attribute__((ext_vector_type(16)));
typedef float f32x4 __attribute__((ext_vector_type(4)));
typedef unsigned u32x4 __attribute__((ext_vector_type(4)));
#define MK_LAS __attribute__((address_space(3)))
constexpr int T = 98304, TP = 65536, D = 1024, FF = 2816, INW = 2304, SEQ = 4096;
constexpr int LDS_BYTES = 133120;
constexpr float INV0 = 1.000000000e+00f, INV1 = 1.939227447e-01f, INV2 = 3.760603093e-02f, INV3 = 7.292664737e-03f, INV4 = 1.414213562e-03f, INV5 = 2.742481757e-04f, INV6 = 5.318295897e-05f, INV7 = 1.031338538e-05f;
constexpr size_t OFF_BIG = 0;
constexpr size_t OFF_MERGED = (size_t)T * FF * 2;
constexpr size_t OFF_XB = OFF_MERGED + (size_t)T * D * 2;
constexpr size_t OFF_LSE = OFF_XB + (size_t)T * D * 2;
constexpr size_t OFF_W = OFF_LSE + (size_t)3 * T * 8 * 4;
constexpr size_t SZ_GU = (size_t)2 * FF * D * 2, SZ_DN = (size_t)D * FF * 2, SZ_IN = (size_t)INW * D * 2, SZ_OUT = (size_t)D * D * 2;
constexpr size_t OFF_GU1 = OFF_W, OFF_DN1 = OFF_GU1 + SZ_GU, OFF_GU2 = OFF_DN1 + SZ_DN, OFF_DN2 = OFF_GU2 + SZ_GU, OFF_WIN = OFF_DN2 + SZ_DN, OFF_WOUT = OFF_WIN + SZ_IN;
constexpr size_t OFF_SS = OFF_WOUT + SZ_OUT;
constexpr size_t OFF_ROPE = OFF_SS + (size_t)5 * T * 4;
constexpr size_t WS_END = OFF_ROPE + (size_t)SEQ * 16 * 4;

struct Args { const float* in[17]; float* out; unsigned char* ws; int ph_lo, ph_hi; };

__device__ __forceinline__ unsigned pk2(float lo, float hi) { return pg8::cvt_pk_bf16(lo, hi); }
__device__ __forceinline__ float wave_sum(float v) {
#pragma unroll
    for (int o = 1; o < 64; o <<= 1) v += __shfl_xor(v, o);
    return v;
}
#define MK_LDS_WAIT() asm volatile("s_waitcnt lgkmcnt(0)" ::: "memory")

__device__ __forceinline__ void p0_weight_item(const float* W0, const float* W1, int kind, int K, int Nsrc, const float* gain0, const float* gain1, bf16_t* WT, MK_LAS float* scr, int item, int nblk, int lane) {
    const int kb = item / nblk, nb = item % nblk, k0 = 64 * kb, n0 = 32 * nb;
    const int R = n0 + (lane & 31);
    const float* src; int col;
    if (kind == 0) { const int n = (R >> 2) & 1; col = 128 * (R >> 8) + 32 * ((R >> 5) & 3) + 8 * ((R >> 3) & 3) + 4 * ((R >> 7) & 1) + (R & 3); src = n ? W1 : W0; }
    else { col = R; src = W0; }
#pragma unroll
    for (int i = 0; i < 32; ++i) { const int kk = 2 * i + (lane >> 5); const int k = k0 + kk;
        float g = 1.0f; if (gain0) g = (gain1 && k >= 512) ? gain1[k - 512] : gain0[k];
        scr[kk * 33 + (lane & 31)] = src[(size_t)k * Nsrc + col] * g; }
    MK_LDS_WAIT();
    const int c = lane & 7;
#pragma unroll
    for (int j = 0; j < 4; ++j) { const int n = (lane >> 3) + 8 * j; const MK_LAS float* s = scr + (8 * c) * 33 + n;
        u32x4 o; o.x = pk2(s[0 * 33], s[1 * 33]); o.y = pk2(s[2 * 33], s[3 * 33]); o.z = pk2(s[4 * 33], s[5 * 33]); o.w = pk2(s[6 * 33], s[7 * 33]);
        *(u32x4*)(WT + (size_t)(n0 + n) * K + k0 + 8 * c) = o; }
    MK_LDS_WAIT();
}

__device__ __forceinline__ void phase_prologue(const Args& a, MK_LAS unsigned char* lds, int gw, int NGW, int wave, int lane) {
    MK_LAS float* scr = (MK_LAS float*)(lds + wave * 8448);
    unsigned char* ws = a.ws;
    constexpr int I_GU = (D / 64) * (2 * FF / 32), I_DN = (FF / 64) * (D / 32), I_IN = (D / 64) * (INW / 32), I_OUT = (D / 64) * (D / 32);
    constexpr int NITEMS = 2 * I_GU + 2 * I_DN + I_IN + I_OUT;
    for (int it = gw; it < NITEMS; it += NGW) {
        int r = it; const float *W0, *W1 = nullptr, *g0 = nullptr, *g1 = nullptr; int kind = 1, K = D, Nsrc = D; size_t woff;
        if (r < 2 * I_GU) { const bool s2 = r >= I_GU; r -= s2 ? I_GU : 0; W0 = a.in[s2 ? 13 : 3]; W1 = a.in[s2 ? 14 : 4]; g0 = a.in[s2 ? 12 : 2]; kind = 0; Nsrc = FF; woff = s2 ? OFF_GU2 : OFF_GU1; }
        else if (r < 2 * I_GU + 2 * I_DN) { r -= 2 * I_GU; const bool s2 = r >= I_DN; r -= s2 ? I_DN : 0; W0 = a.in[s2 ? 15 : 5]; K = FF; woff = s2 ? OFF_DN2 : OFF_DN1; }
        else if (r < 2 * I_GU + 2 * I_DN + I_IN) { r -= 2 * I_GU + 2 * I_DN; W0 = a.in[7]; g0 = a.in[6]; Nsrc = INW; woff = OFF_WIN; }
        else { r -= 2 * I_GU + 2 * I_DN + I_IN; W0 = a.in[11]; g0 = a.in[9]; g1 = a.in[10]; woff = OFF_WOUT; }
        const int nblk = (kind == 0 ? 2 * FF : Nsrc) / 32;
        p0_weight_item(W0, W1, kind, K, Nsrc, g0, g1, (bf16_t*)(ws + woff), scr, r, nblk, lane);
    }
    bf16_t* xb = (bf16_t*)(ws + OFF_XB); float* ss = (float*)(ws + OFF_SS);
    constexpr int RB = 4;
    for (int row0 = gw * RB; row0 < T; row0 += NGW * RB) {
        f32x4 v[RB][4];
#pragma unroll
        for (int q = 0; q < RB; ++q) { const int row = row0 + q; const float* xr = row < TP ? a.in[0] + (size_t)row * D : a.in[1] + (size_t)(row - TP) * D;
#pragma unroll
            for (int j = 0; j < 2; ++j) { v[q][2 * j] = *(const f32x4*)(xr + j * 512 + lane * 8); v[q][2 * j + 1] = *(const f32x4*)(xr + j * 512 + lane * 8 + 4); } }
#pragma unroll
        for (int q = 0; q < RB; ++q) { const int row = row0 + q; float s = 0.f;
#pragma unroll
            for (int j = 0; j < 2; ++j) { const f32x4 v0 = v[q][2 * j], v1 = v[q][2 * j + 1];
                s += (v0[0] * v0[0] + v0[1] * v0[1]) + (v0[2] * v0[2] + v0[3] * v0[3]) + (v1[0] * v1[0] + v1[1] * v1[1]) + (v1[2] * v1[2] + v1[3] * v1[3]);
                u32x4 w; w.x = pk2(v0[0], v0[1]); w.y = pk2(v0[2], v0[3]); w.z = pk2(v1[0], v1[1]); w.w = pk2(v1[2], v1[3]);
                *(u32x4*)(xb + (size_t)row * D + j * 512 + lane * 8) = w; }
            s = wave_sum(s);
            if (lane == 0) { ss[row] = s; ss[T + row] = 0.f; ss[2 * T + row] = 0.f; ss[3 * T + row] = 0.f; } }
    }
    float* rope = (float*)(ws + OFF_ROPE);
    for (int i = gw * 64 + lane; i < SEQ * 8; i += NGW * 64) {
        const int pos = i >> 3, j = i & 7;
        const float inv = j == 0 ? INV0 : j == 1 ? INV1 : j == 2 ? INV2 : j == 3 ? INV3 : j == 4 ? INV4 : j == 5 ? INV5 : j == 6 ? INV6 : INV7;
        const float ang = (float)pos * inv;
        double tr = (double)ang * 0.15915494309189535; tr -= __builtin_floor(tr);
        const float fr = (float)tr;
        rope[pos * 16 + j] = __builtin_amdgcn_cosf(fr); rope[pos * 16 + 8 + j] = __builtin_amdgcn_sinf(fr);
    }
}

__device__ __forceinline__ int crow(int r, int hi) { return (r & 3) + 8 * (r >> 2) + 4 * hi; }
typedef short v4i16_t __attribute__((ext_vector_type(4)));
__device__ __forceinline__ s16x4 vtr(const MK_LAS unsigned char* p) { return __builtin_bit_cast(s16x4, __builtin_amdgcn_ds_read_tr16_b64_v4i16((MK_LAS v4i16_t*)p)); }
#define MK_MFMA32(a, b, c) __builtin_amdgcn_mfma_f32_32x32x16_bf16(a, b, c, 0, 0, 0)
constexpr int ATT_NK = 384, ATT_KCS = (ATT_NK + 1) * 16  , ATT_VOFF = 49408, ATT_VDS = ATT_NK * 64  , ATT_WOFF = ATT_VOFF + 2 * ATT_VDS, ATT_WSZ = 4224;
static_assert(8 * ATT_KCS <= ATT_VOFF && ATT_WOFF + 8 * ATT_WSZ <= LDS_BYTES, "attention LDS map");
constexpr float ATT_THR = 8.0f;
#define MK_WAIT_BAR() asm volatile("s_waitcnt lgkmcnt(0)\n\ts_barrier" ::: "memory")

struct AttItem {
    size_t rowbase;
    int qcol, kcol, vcol;
    int stride, res, hw, L;
    int kb0, NK;
    int q0;
    int isA;
    bf16_t* out; int out_ld, out_col;
    float* lse;
};
__device__ __forceinline__ void att_decode(const Args& a, int id, AttItem& I) {
    unsigned char* ws = a.ws;
    bf16_t* merged = (bf16_t*)(ws + OFF_MERGED);
    constexpr int NA = 24 * 2 * 64;
    if (id < NA) {
        const int n = id >> 7, kvh = (id >> 6) & 1, qb = id & 63;
        I.rowbase = (size_t)n * SEQ; I.qcol = kvh * 256; I.kcol = 512 + kvh * 64; I.vcol = 640 + kvh * 64;
        I.stride = 1; I.res = 0; I.hw = 128; I.L = SEQ; I.kb0 = 64 * qb - 128; I.NK = 320; I.q0 = 64 * qb; I.isA = 1;
        I.out = merged; I.out_ld = 1024; I.out_col = kvh * 256; I.lse = nullptr;
    } else {
        const int idb = id - NA; const int n = idb / 384, rem = idb - n * 384, h = rem / 48, k = rem - h * 48, g = k >> 4, f = k & 15;
        const int sh = 2 * g, dd = 1 << sh, c = f >> sh;
        I.rowbase = (size_t)n * SEQ; I.qcol = 768 + h * 64; I.kcol = 1280 + h * 64; I.vcol = 1792 + h * 64;
        I.stride = dd; I.res = f & (dd - 1); I.hw = 64; I.L = SEQ >> sh; I.kb0 = 256 * c - 64; I.NK = 384; I.q0 = 256 * c; I.isA = 0;
        if (g == 0) { I.out = merged; I.out_ld = 1024; I.out_col = 512 + h * 64; }
        else { I.out = (bf16_t*)a.out + (size_t)(g - 1) * T * 512; I.out_ld = 512; I.out_col = h * 64; }
        I.lse = (float*)(ws + OFF_LSE) + (size_t)g * T * 8 + h;
    }
}
__device__ __forceinline__ void att_prefetch(const bf16_t* __restrict__ proj, const AttItem& I, int tid, int wave, u32x4 (&kr)[6], u32x4 (&vr)[6], bf16x8 (&qr)[4]) {
    const size_t tokstride = (size_t)I.stride * INW;
    {
        const int lane = tid & 63, r32 = lane & 31, hi = lane >> 5;
        const int hsel = I.isA ? (wave & 3) : 0, t0 = I.q0 + 32 * (I.isA ? (wave >> 2) : wave);
        const bf16_t* qp = proj + (I.rowbase + I.res) * INW + (size_t)(t0 + r32) * tokstride + I.qcol + hsel * 64 + hi * 8;
#pragma unroll
        for (int d0 = 0; d0 < 4; ++d0) qr[d0] = *(const bf16x8*)(qp + d0 * 16);
    }
    const bf16_t* seq0 = proj + (I.rowbase + I.res) * INW + (tid & 7) * 8;
#pragma unroll
    for (int i = 0; i < 6; ++i) {
        const int row = i * 64 + (tid >> 3), key = I.kb0 + row;
        if (row < I.NK && key >= 0 && key < I.L) { const bf16_t* p = seq0 + (size_t)key * tokstride; kr[i] = *(const u32x4*)(p + I.kcol); vr[i] = *(const u32x4*)(p + I.vcol); }
        else { kr[i] = (u32x4){0u, 0u, 0u, 0u}; vr[i] = (u32x4){0u, 0u, 0u, 0u}; }
    }
}
__device__ __forceinline__ void att_store(MK_LAS unsigned char* lds, int tid, const u32x4 (&kr)[6], const u32x4 (&vr)[6]) {
    const int chunk = tid & 7;
    MK_LAS unsigned char* kp = lds + chunk * ATT_KCS + (tid >> 3) * 16;
    MK_LAS unsigned char* vp = lds + ATT_VOFF + (chunk >> 2) * ATT_VDS + (tid >> 3) * 64 + (chunk & 3) * 16;
#pragma unroll
    for (int i = 0; i < 6; ++i) { *(MK_LAS u32x4*)(kp + i * 64 * 16) = kr[i]; *(MK_LAS u32x4*)(vp + i * 64 * 64) = vr[i]; }
}

__device__ __forceinline__ void att_compute(const Args& a, const AttItem& I, MK_LAS unsigned char* lds, int wave, int lane, const bf16x8 (&qr)[4], const bool do_store) {
    const int r32 = lane & 31, hi = lane >> 5;
    MK_LAS unsigned char* wl = lds + ATT_WOFF + wave * ATT_WSZ;
    MK_LAS float* wsf = (MK_LAS float*)(wl + 4096);
    const int hsel = I.isA ? (wave & 3) : 0;
    const int t0 = I.q0 + 32 * (I.isA ? (wave >> 2) : wave);
    const int ocol = I.out_col + hsel * 64;
    const int nkt = I.hw / 16 + 1;
    const int kt_lo = t0 >= I.hw ? 0 : ((I.hw - t0) >> 5);
    int kt_hi = (I.L - t0 + I.hw) >> 5; kt_hi = kt_hi < nkt ? kt_hi : nkt;
    float sink_l2 = 0.f; if (I.isA) sink_l2 = a.in[8][(I.qcol >> 6) + hsel] * 1.4426950408889634f;
    const MK_LAS unsigned char* kfb = lds + hi * ATT_KCS + r32 * 16;
    const MK_LAS unsigned char* vfb = lds + ATT_VOFF + ((lane >> 4) & 1) * 32 + (lane & 3) * 8 + (4 * hi + ((lane & 15) >> 2)) * 64;
    float mhat = -1.0e4f, lsum = 0.f;
    f32x16 o0 = {}, o1 = {};
    for (int kt = kt_lo; kt < kt_hi; ++kt) {
        const int krow0 = t0 - I.hw + 32 * kt - I.kb0;
        const MK_LAS unsigned char* kp = kfb + krow0 * 16;
        bf16x8 kf[4];
#pragma unroll
        for (int d0 = 0; d0 < 4; ++d0) kf[d0] = *(const MK_LAS bf16x8*)(kp + 2 * d0 * ATT_KCS);
        const MK_LAS unsigned char* vp = vfb + krow0 * 64;
#define MK_VFR(off) __builtin_shufflevector(vtr(vp + (off)), vtr(vp + (off) + 512), 0, 1, 2, 3, 4, 5, 6, 7)
        const bf16x8 v00 = MK_VFR(0), v01 = MK_VFR(ATT_VDS), v10 = MK_VFR(1024), v11 = MK_VFR(ATT_VDS + 1024);
#undef MK_VFR
        f32x16 p = {};
#pragma unroll
        for (int d0 = 0; d0 < 4; ++d0) p = MK_MFMA32(kf[d0], qr[d0], p);
        if (kt == 0) {
#pragma unroll
            for (int r = 0; r < 16; ++r) if (crow(r, hi) < r32) p[r] = -1.0e30f;
        }
        if (kt == nkt - 1) {
#pragma unroll
            for (int r = 0; r < 16; ++r) if (crow(r, hi) > r32) p[r] = -1.0e30f;
        }
        float rm = __builtin_fmaxf(p[0], p[1]);
#pragma unroll
        for (int r = 2; r < 16; ++r) rm = __builtin_fmaxf(rm, p[r]);
        rm = __builtin_fmaxf(rm, __shfl_xor(rm, 32));
        if (__any(rm > mhat + ATT_THR)) {
            const float mnew = __builtin_fmaxf(mhat, rm), f = __builtin_amdgcn_exp2f(mhat - mnew);
            lsum *= f; mhat = mnew;
            if (hi == 0) wsf[r32] = f;
            MK_LDS_WAIT();
#pragma unroll
            for (int g = 0; g < 4; ++g) { const f32x4 w4 = *(const MK_LAS f32x4*)(wsf + 8 * g + 4 * hi);
#pragma unroll
                for (int j = 0; j < 4; ++j) { o0[4 * g + j] *= w4[j]; o1[4 * g + j] *= w4[j]; } }
            MK_LDS_WAIT();
        }
        float sacc = 0.f;
#pragma unroll
        for (int r = 0; r < 16; ++r) { p[r] = __builtin_amdgcn_exp2f(p[r] - mhat); sacc += p[r]; }
        lsum += sacc;
        u32x4 pw0, pw1;
        pw0.x = pk2(p[0], p[1]); pw0.y = pk2(p[2], p[3]); pw0.z = pk2(p[4], p[5]); pw0.w = pk2(p[6], p[7]);
        pw1.x = pk2(p[8], p[9]); pw1.y = pk2(p[10], p[11]); pw1.z = pk2(p[12], p[13]); pw1.w = pk2(p[14], p[15]);
        o0 = MK_MFMA32(__builtin_bit_cast(bf16x8, pw0), v00, o0); o1 = MK_MFMA32(__builtin_bit_cast(bf16x8, pw0), v01, o1);
        o0 = MK_MFMA32(__builtin_bit_cast(bf16x8, pw1), v10, o0); o1 = MK_MFMA32(__builtin_bit_cast(bf16x8, pw1), v11, o1);
    }
    float ltot = lsum + __shfl_xor(lsum, 32);
    if (I.isA) ltot += __builtin_amdgcn_exp2f(sink_l2 - mhat);
    const float rl = 1.0f / ltot;
    if (hi == 0) wsf[r32] = rl;
    MK_LDS_WAIT();
    MK_LAS bf16_t* stg = (MK_LAS bf16_t*)wl;
#pragma unroll
    for (int g = 0; g < 4; ++g) { const f32x4 w4 = *(const MK_LAS f32x4*)(wsf + 8 * g + 4 * hi);
#pragma unroll
        for (int j = 0; j < 4; ++j) { const int r = 4 * g + j, orow = crow(r, hi);
            stg[orow * 64 + r32] = (bf16_t)(pk2(o0[r] * w4[j], 0.f) & 0xffffu); stg[orow * 64 + 32 + r32] = (bf16_t)(pk2(o1[r] * w4[j], 0.f) & 0xffffu); } }
    MK_LDS_WAIT();
    if (do_store) {
#pragma unroll
    for (int i = 0; i < 4; ++i) { const int row = i * 8 + (lane >> 3), ch = lane & 7;
        *(u32x4*)(I.out + (I.rowbase + I.res + (size_t)I.stride * (t0 + row)) * I.out_ld + ocol + ch * 8) = *(const MK_LAS u32x4*)(stg + row * 64 + ch * 8); }
    }
    if (do_store && I.lse && hi == 0) I.lse[(I.rowbase + I.res + (size_t)I.stride * (t0 + r32)) * 8] = mhat + __builtin_log2f(ltot);
}

__device__ __forceinline__ void phase_attention(const Args& a, MK_LAS unsigned char* lds, int vcu, int G, int tid, int wave, int lane, const int mode) {
    const bf16_t* proj = (const bf16_t*)(a.ws + OFF_BIG);
    constexpr int NITEMS = 24 * 2 * 64 + 24 * 8 * 48;
    u32x4 kr[6], vr[6]; bf16x8 qn[4];
    int id = vcu;
    AttItem I;
#pragma unroll
    for (int i = 0; i < 6; ++i) { kr[i] = (u32x4){0u, 0u, 0u, 0u}; vr[i] = kr[i]; }
#pragma unroll
    for (int i = 0; i < 4; ++i) qn[i] = (bf16x8){0, 0, 0, 0, 0, 0, 0, 0};
    if (id < NITEMS) { att_decode(a, id, I); if (mode != 1) att_prefetch(proj, I, tid, wave, kr, vr, qn); }
    while (id < NITEMS) {
        if (mode != 1) att_store(lds, tid, kr, vr);
        bf16x8 qr[4];
#pragma unroll
        for (int d0 = 0; d0 < 4; ++d0) qr[d0] = qn[d0];
        MK_WAIT_BAR();
        const int nid = id + G;
        if (nid < NITEMS && mode != 1) { AttItem N; att_decode(a, nid, N); att_prefetch(proj, N, tid, wave, kr, vr, qn); }
        if (mode != 2) att_compute(a, I, lds, wave, lane, qr, mode == 0);
        MK_WAIT_BAR();
        id = nid;
        if (id < NITEMS) att_decode(a, id, I);
    }
}

__device__ __forceinline__ void unpack8(const u32x4 w, float (&v)[8]) {
    v[0] = __uint_as_float(w.x << 16); v[1] = __uint_as_float(w.x & 0xffff0000u); v[2] = __uint_as_float(w.y << 16); v[3] = __uint_as_float(w.y & 0xffff0000u);
    v[4] = __uint_as_float(w.z << 16); v[5] = __uint_as_float(w.z & 0xffff0000u); v[6] = __uint_as_float(w.w << 16); v[7] = __uint_as_float(w.w & 0xffff0000u);
}
__device__ __forceinline__ u32x4 pack8(const float (&v)[8], float s) { u32x4 w; w.x = pk2(v[0] * s, v[1] * s); w.y = pk2(v[2] * s, v[3] * s); w.z = pk2(v[4] * s, v[5] * s); w.w = pk2(v[6] * s, v[7] * s); return w; }
__device__ __forceinline__ void phase_finalize(const Args& a, int gw, int NGW, int lane) {
    unsigned char* ws = a.ws;
    bf16_t* merged = (bf16_t*)(ws + OFF_MERGED); const bf16_t* ob2 = (const bf16_t*)a.out; const bf16_t* ob3 = ob2 + (size_t)T * 512; const float* lse = (const float*)(ws + OFF_LSE);
    const int h = lane >> 3;
    constexpr int RB = 4;
    for (int row0 = gw * RB; row0 < T; row0 += NGW * RB) {
        u32x4 wa[RB], w1[RB], w2[RB], w3[RB]; float l1[RB], l2[RB], l3[RB];
#pragma unroll
        for (int q = 0; q < RB; ++q) { const size_t row = row0 + q; const bf16_t* mr = merged + row * 1024;
            wa[q] = *(const u32x4*)(mr + lane * 8); w1[q] = *(const u32x4*)(mr + 512 + lane * 8);
            w2[q] = *(const u32x4*)(ob2 + row * 512 + lane * 8); w3[q] = *(const u32x4*)(ob3 + row * 512 + lane * 8);
            l1[q] = lse[row * 8 + h]; l2[q] = lse[(size_t)T * 8 + row * 8 + h]; l3[q] = lse[(size_t)2 * T * 8 + row * 8 + h]; }
#pragma unroll
        for (int q = 0; q < RB; ++q) { bf16_t* mr = merged + (size_t)(row0 + q) * 1024;
            float va[8], b1[8], b2[8], b3[8];
            unpack8(wa[q], va); unpack8(w1[q], b1); unpack8(w2[q], b2); unpack8(w3[q], b3);
            const float mx = __builtin_fmaxf(l1[q], __builtin_fmaxf(l2[q], l3[q]));
            const float e1 = __builtin_amdgcn_exp2f(l1[q] - mx), e2 = __builtin_amdgcn_exp2f(l2[q] - mx), e3 = __builtin_amdgcn_exp2f(l3[q] - mx), ri = 1.0f / (e1 + e2 + e3);
            const float c1 = e1 * ri, c2 = e2 * ri, c3 = e3 * ri;
            float sa = 0.f, sb = 0.f;
#pragma unroll
            for (int j = 0; j < 8; ++j) { b1[j] = c1 * b1[j] + c2 * b2[j] + c3 * b3[j]; sa += va[j] * va[j]; sb += b1[j] * b1[j]; }
            sa = wave_sum(sa); sb = wave_sum(sb);
            const float ra = __builtin_amdgcn_rsqf(sa * (1.0f / 512.0f) + 1e-6f), rb = __builtin_amdgcn_rsqf(sb * (1.0f / 512.0f) + 1e-6f);
            *(u32x4*)(mr + lane * 8) = pack8(va, ra);
            *(u32x4*)(mr + 512 + lane * 8) = pack8(b1, rb); }
    }
}

__device__ __forceinline__ void phase_final_norm(const Args& a, int gw, int NGW, int lane) {
    const float* ss = (const float*)(a.ws + OFF_SS) + (size_t)3 * T; const float* gain = a.in[16];
    f32x4 g[4];
#pragma unroll
    for (int j = 0; j < 4; ++j) g[j] = *(const f32x4*)(gain + j * 256 + lane * 4);
    constexpr int RB = 4;
    for (int row0 = gw * RB; row0 < T; row0 += NGW * RB) {
        f32x4 v[RB][4]; float rs[RB];
#pragma unroll
        for (int q = 0; q < RB; ++q) { const float* xr = a.out + (size_t)(row0 + q) * D; rs[q] = ss[row0 + q];
#pragma unroll
            for (int j = 0; j < 4; ++j) v[q][j] = *(const f32x4*)(xr + j * 256 + lane * 4); }
#pragma unroll
        for (int q = 0; q < RB; ++q) { float* xr = a.out + (size_t)(row0 + q) * D; const float r = pg8::rstd_of(rs[q]);
#pragma unroll
            for (int j = 0; j < 4; ++j) *(f32x4*)(xr + j * 256 + lane * 4) = v[q][j] * r * g[j]; }
    }
}

constexpr int NPHASE = 10;
#ifndef MK_MASK
#define MK_MASK 0x3ff
#endif
#define MK_ON(p) ((MK_MASK >> (p)) & 1)
__global__ __launch_bounds__(512) void mk_fwd(const Args a) {
    extern __shared__ __attribute__((aligned(16))) unsigned char lds_raw[];
    MK_LAS unsigned char* lds = (MK_LAS unsigned char*)lds_raw;
    cg::grid_group grid = cg::this_grid();
#ifndef MK_REP
#define MK_REP 0
#endif
#ifndef MK_GU_PROBE
#define MK_GU_PROBE 1
#endif
#ifndef MK_ATT_PROBE
#define MK_ATT_PROBE 0
#endif
    for (int ph2 = a.ph_lo * 2; ph2 < a.ph_hi * 2; ++ph2) {
        const int ph = ph2 >> 1;
        if ((ph2 & 1) && !((MK_REP >> ph) & 1)) continue;
        if (ph2 > a.ph_lo * 2) grid.sync();
        int tid = threadIdx.x; asm volatile("" : "+v"(tid));
        const int lane = tid & 63, wave = __builtin_amdgcn_readfirstlane(tid >> 6);
        int G = gridDim.x, bid = blockIdx.x; asm volatile("" : "+s"(G), "+s"(bid));
        const int vcu = (bid & 7) * (G >> 3) + (bid >> 3);
        const int gw = vcu * 8 + wave, NGW = G * 8;
        unsigned char* ws = a.ws; asm volatile("" : "+s"(ws));
        float* ss = (float*)(ws + OFF_SS);
        if (MK_ON(0) && ph == 0) phase_prologue(a, lds, gw, NGW, wave, lane);
        else if (MK_ON(1) && (ph == 1 || ph == 7)) {
            const bool second = ph == 7;
            pg8::Gemm g; g.A = (const bf16_t*)(ws + OFF_XB); g.Bt = (const bf16_t*)(ws + (second ? OFF_GU2 : OFF_GU1)); g.M = T; g.N = 2 * FF; g.K = D;
            pg8::StaticOrder S; S.init(T, 2 * FF, G, bid);
            pg8::EpiGateUp E; E.H = (bf16_t*)(ws + OFF_BIG); E.ss = ss + (second ? 2 * (size_t)T : 0); E.enabled = (ph2 & 1) ? MK_GU_PROBE : 1;
            pg8::gemm_phase<pg8::EpiGateUp, pg8::StaticOrder, true, true>(lds, g, S, E, tid);
        } else if (MK_ON(2) && (ph == 2 || ph == 6 || ph == 8)) {
            pg8::Gemm g; pg8::EpiResid E; E.split = TP; E.res_lo = a.in[0]; E.res_hi = a.in[1]; E.xb = (bf16_t*)(ws + OFF_XB);
            if (ph == 2) { g.A = (const bf16_t*)(ws + OFF_BIG); g.Bt = (const bf16_t*)(ws + OFF_DN1); g.K = FF; E.out = nullptr; E.res_bf16 = 0; E.write_xb = 1; E.ssout = ss + T; E.alpha = 0.5f; }
            else if (ph == 6) { g.A = (const bf16_t*)(ws + OFF_MERGED); g.Bt = (const bf16_t*)(ws + OFF_WOUT); g.K = D; E.out = nullptr; E.res_bf16 = 1; E.write_xb = 1; E.ssout = ss + 2 * (size_t)T; E.alpha = 1.0f; }
            else { g.A = (const bf16_t*)(ws + OFF_BIG); g.Bt = (const bf16_t*)(ws + OFF_DN2); g.K = FF; E.out = a.out; E.res_bf16 = 1; E.write_xb = 0; E.ssout = ss + 3 * (size_t)T; E.alpha = 0.5f; }
            g.M = T; g.N = D;
            pg8::StaticOrder S; S.init(T, D, G, bid);
            pg8::gemm_phase<pg8::EpiResid, pg8::StaticOrder, true, true>(lds, g, S, E, tid);
        } else if (MK_ON(3) && ph == 3) {
            pg8::Gemm g; g.A = (const bf16_t*)(ws + OFF_XB); g.Bt = (const bf16_t*)(ws + OFF_WIN); g.M = T; g.N = INW; g.K = D;
            pg8::StaticOrder S; S.init(T, INW, G, bid);
            pg8::EpiQkv E; E.P = (bf16_t*)(ws + OFF_BIG); E.ss = ss + T; E.rope = (const float*)(ws + OFF_ROPE);
            pg8::gemm_phase<pg8::EpiQkv, pg8::StaticOrder, true, true>(lds, g, S, E, tid);
        } else if (MK_ON(4) && ph == 4) phase_attention(a, lds, vcu, G, tid, wave, lane, (ph2 & 1) ? MK_ATT_PROBE : 0);
        else if (MK_ON(5) && ph == 5) phase_finalize(a, gw, NGW, lane);
        else if (MK_ON(9) && ph == 9) phase_final_norm(a, gw, NGW, lane);
    }
}
}

#ifndef MK_N_LAUNCHES
#define MK_N_LAUNCHES 1
#endif
extern "C" void kernel_launch(void* const* d_in, const int* in_sizes, int n_in, void* d_out, int out_size, void* d_ws, size_t ws_size, hipStream_t stream) {
    static int grid = 0;
    if (grid == 0) {
        if (n_in != 17 || out_size != mk::T * mk::D || ws_size < mk::WS_END) { fprintf(stderr, "kernel_launch: unexpected shapes (n_in %d out %d ws %zu need %zu)\n", n_in, out_size, ws_size, (size_t)mk::WS_END); grid = -1; return; }
        int dev = 0, cus = 0, per_cu = 0;
        hipGetDevice(&dev); hipDeviceGetAttribute(&cus, hipDeviceAttributeMultiprocessorCount, dev);
        if (hipFuncSetAttribute((const void*)mk::mk_fwd, hipFuncAttributeMaxDynamicSharedMemorySize, mk::LDS_BYTES) != hipSuccess) { fprintf(stderr, "kernel_launch: hipFuncSetAttribute failed\n"); grid = -1; return; }
        if (hipOccupancyMaxActiveBlocksPerMultiprocessor(&per_cu, (const void*)mk::mk_fwd, 512, mk::LDS_BYTES) != hipSuccess || per_cu < 1) { fprintf(stderr, "kernel_launch: occupancy query says %d\n", per_cu); per_cu = 1; }
        (void)hipGetLastError();
        grid = cus * 1;
        if (grid % 8) grid -= grid % 8;
    }
    if (grid < 0) return;
    mk::Args a{};
    for (int i = 0; i < 17; ++i) a.in[i] = (const float*)d_in[i];
    a.out = (float*)d_out; a.ws = (unsigned char*)d_ws;
#if MK_N_LAUNCHES == 1
    a.ph_lo = 0; a.ph_hi = 10;
    void* args[] = {(void*)&a};
    hipError_t e = hipLaunchCooperativeKernel((const void*)mk::mk_fwd, dim3(grid), dim3(512), args, mk::LDS_BYTES, stream);
    if (e != hipSuccess) fprintf(stderr, "kernel_launch: cooperative launch failed: %s (grid %d)\n", hipGetErrorString(e), grid);
#else
    for (int p = 0; p < 10; ++p) { a.ph_lo = p; a.ph_hi = p + 1; hipLaunchKernelGGL(mk::mk_fwd, dim3(grid), dim3(512), mk::LDS_BYTES, stream, a); }
#endif
}
```

```cpp
#include <hip/hip_runtime.h>
#include <hip/hip_cooperative_groups.h>
#include <cstdio>
#include <cstdint>
namespace cg = cooperative_groups;
namespace pg8 {
#define PG8_LAS __attribute__((address_space(3)))
typedef unsigned short bf16_t;
typedef short bf16x8 __attribute__((ext_vector_type(8)));
typedef float f32x4 __attribute__((ext_vector_type(4)));
typedef unsigned u32x4 __attribute__((ext_vector_type(4)));
constexpr int BM = 256, BK = 64, HALF = 128, HTB = HALF * BK * 2  , STAGE_BYTES = 8 * HTB, NXCD = 8, WGM = 8;

__host__ __device__ __forceinline__ int lds_byte(int r, int c) { const int st = (r >> 4) * 2 + (c >> 5), rr = r & 15, cc = c & 31, ob = rr * 64 + cc * 2; return st * 1024 + (ob ^ (((ob >> 9) & 1) << 5)); }
__host__ __device__ __forceinline__ void stage_rc(int b, int& R, int& C) { const int st = b / 1024, sb = b % 1024, swz = sb ^ (((sb >> 9) & 1) << 5); R = (st >> 1) * 16 + swz / 64; C = (st & 1) * 32 + (swz % 64) / 2; }
__host__ __device__ __forceinline__ int perm32(int rho) { const int n = rho >> 4, i = rho & 15; return 8 * (i >> 2) + 4 * n + (i & 3); }

struct Unit { int pm, pn; };
struct Gemm { const bf16_t* A; const bf16_t* Bt; int M, N, K; int a_blocked; };

struct StaticOrder {
    int nM, nN, nwg, G, c;
    __host__ __device__ void init(int M, int N, int G_, int c_) { nM = M / BM; nN = N / BM; nwg = nM * nN; G = G_; c = c_; }
    __host__ __device__ bool next(int i, Unit& u) const {
        const long L = (long)i * G + c; if (L >= nwg) return false;
        int wgid = (int)L; { const int q = nwg / NXCD, r = nwg % NXCD, xcd = wgid % NXCD, off = wgid / NXCD; wgid = (xcd < r ? xcd * (q + 1) : r * (q + 1) + (xcd - r) * q) + off; }
        const int nig = WGM * nN, gid = wgid / nig, fm = gid * WGM, gsz = (nM - fm) < WGM ? (nM - fm) : WGM;
        u.pm = fm + ((wgid % nig) % gsz); u.pn = (wgid % nig) / gsz; return true;
    }
    __device__ __forceinline__ void a_ready(const Unit&) const {}
    __device__ __forceinline__ void done(const Unit&) const {}
};
__device__ __forceinline__ unsigned cvt_pk_bf16(float lo, float hi) { unsigned r; asm volatile("v_cvt_pk_bf16_f32 %0, %1, %2" : "=v"(r) : "v"(lo), "v"(hi)); return r; }

__device__ __forceinline__ size_t blk1024(int row, int col) { return (((size_t)(row >> 8) * 16 + (col >> 6)) * 256 + (row & 255)) * 64 + (col & 63); }
__device__ __forceinline__ float silu_f(float x) { return x * __builtin_amdgcn_rcpf(1.0f + __builtin_amdgcn_exp2f(-1.4426950408889634f * x)); }
__device__ __forceinline__ float rstd_of(float ss) { return __builtin_amdgcn_rsqf(ss * (1.0f / 1024.0f) + 1e-6f); }

struct EpiGateUp {
    static constexpr bool PERM = true, AFTER_DRAIN = false;
    bf16_t* H; const float* ss; int enabled;
    __device__ __forceinline__ void operator()(const f32x4 (&acc)[2][2][4][2], const Unit& u, int wr, int wc, int fr, int fq) const {
        if (!enabled) return;
        const int row0 = u.pm * BM + wr * 64 + fr, hcol = u.pn * 128 + wc * 32 + fq * 8;
        float ssv[2][4];
#pragma unroll
        for (int ai = 0; ai < 2; ++ai)
#pragma unroll
            for (int m = 0; m < 4; ++m) ssv[ai][m] = ss[row0 + ai * HALF + m * 16];
#pragma unroll
        for (int ai = 0; ai < 2; ++ai)
#pragma unroll
            for (int m = 0; m < 4; ++m) {
                const int row = row0 + ai * HALF + m * 16; const float rs = rstd_of(ssv[ai][m]);
                const f32x4 g0 = acc[ai][0][m][0] * rs, g1 = acc[ai][1][m][0] * rs, u0 = acc[ai][0][m][1] * rs, u1 = acc[ai][1][m][1] * rs;
                u32x4 w;
                w.x = cvt_pk_bf16(silu_f(g0[0]) * u0[0], silu_f(g0[1]) * u0[1]); w.y = cvt_pk_bf16(silu_f(g0[2]) * u0[2], silu_f(g0[3]) * u0[3]);
                w.z = cvt_pk_bf16(silu_f(g1[0]) * u1[0], silu_f(g1[1]) * u1[1]); w.w = cvt_pk_bf16(silu_f(g1[2]) * u1[2], silu_f(g1[3]) * u1[3]);
                *(u32x4*)(H + (((size_t)u.pm * 44 + (hcol >> 6)) * 256 + (row & 255)) * 64 + (hcol & 63)) = w;
                asm volatile("" ::: "memory");
            }
    }
};

struct EpiResid {
    static constexpr bool PERM = true, AFTER_DRAIN = false;
    const float* res_lo; const float* res_hi; int split;
    float* out; bf16_t* xb; float* ssout; float alpha; int res_bf16, write_xb;
    __device__ __forceinline__ void operator()(const f32x4 (&acc)[2][2][4][2], const Unit& u, int wr, int wc, int fr, int fq) const {
        const int row0 = u.pm * BM + wr * 64 + fr, col0 = u.pn * BM + wc * 32 + fq * 8;
        const float* rbase = (u.pm * BM < split) ? res_lo : res_hi - (size_t)split * 1024;
        auto row_out = [&](const int ai, const int m, const f32x4 (&r0)[2], const f32x4 (&r1)[2]) {
            const int row = row0 + ai * HALF + m * 16; float s = 0.f;
#pragma unroll
            for (int bj = 0; bj < 2; ++bj) {
                const size_t off = (size_t)row * 1024 + col0 + bj * HALF;
                const f32x4 v0 = r0[bj] + alpha * acc[ai][bj][m][0], v1 = r1[bj] + alpha * acc[ai][bj][m][1];
                if (out) { *(f32x4*)(out + off) = v0; *(f32x4*)(out + off + 4) = v1; }
                if (write_xb) { u32x4 w; w.x = cvt_pk_bf16(v0[0], v0[1]); w.y = cvt_pk_bf16(v0[2], v0[3]); w.z = cvt_pk_bf16(v1[0], v1[1]); w.w = cvt_pk_bf16(v1[2], v1[3]); *(u32x4*)(xb + blk1024(row, col0 + bj * HALF)) = w; }
                s += (v0[0] * v0[0] + v0[1] * v0[1]) + (v0[2] * v0[2] + v0[3] * v0[3]) + (v1[0] * v1[0] + v1[1] * v1[1]) + (v1[2] * v1[2] + v1[3] * v1[3]);
            }
            s += __shfl_xor(s, 16); s += __shfl_xor(s, 32);
            if (fq == 0) atomicAdd(ssout + row, s);
        };
        if (res_bf16) {
            u32x4 rb[2][4][2];
#pragma unroll
            for (int ai = 0; ai < 2; ++ai)
#pragma unroll
                for (int m = 0; m < 4; ++m)
#pragma unroll
                    for (int bj = 0; bj < 2; ++bj) rb[ai][m][bj] = *(const u32x4*)(xb + blk1024(row0 + ai * HALF + m * 16, col0 + bj * HALF));
#pragma unroll
            for (int ai = 0; ai < 2; ++ai) {
#pragma unroll
                for (int m = 0; m < 4; ++m) { f32x4 r0[2], r1[2];
#pragma unroll
                    for (int bj = 0; bj < 2; ++bj) { const u32x4 w = rb[ai][m][bj];
                        r0[bj] = (f32x4){__uint_as_float(w.x << 16), __uint_as_float(w.x & 0xffff0000u), __uint_as_float(w.y << 16), __uint_as_float(w.y & 0xffff0000u)};
                        r1[bj] = (f32x4){__uint_as_float(w.z << 16), __uint_as_float(w.z & 0xffff0000u), __uint_as_float(w.w << 16), __uint_as_float(w.w & 0xffff0000u)}; }
                    row_out(ai, m, r0, r1); }
                asm volatile("" ::: "memory");
            }
        } else {
#pragma unroll
            for (int ai = 0; ai < 2; ++ai) {
                f32x4 rr[4][2][2];
#pragma unroll
                for (int m = 0; m < 4; ++m)
#pragma unroll
                    for (int bj = 0; bj < 2; ++bj) { const size_t off = (size_t)(row0 + ai * HALF + m * 16) * 1024 + col0 + bj * HALF;
                        rr[m][bj][0] = *(const f32x4*)(rbase + off); rr[m][bj][1] = *(const f32x4*)(rbase + off + 4); }
#pragma unroll
                for (int m = 0; m < 4; ++m) { const f32x4 r0[2] = {rr[m][0][0], rr[m][1][0]}, r1[2] = {rr[m][0][1], rr[m][1][1]}; row_out(ai, m, r0, r1); }
                asm volatile("" ::: "memory");
            }
        }
    }
};

struct EpiQkv {
    static constexpr bool PERM = true, AFTER_DRAIN = false;
    bf16_t* P; const float* ss; const float* rope;
    __device__ __forceinline__ void operator()(const f32x4 (&acc)[2][2][4][2], const Unit& u, int wr, int wc, int fr, int fq) const {
        const int row0 = u.pm * BM + wr * 64 + fr, col0 = u.pn * BM + wc * 32 + fq * 8; const int pn = u.pn;
        const bool isq = (pn <= 1) || (pn == 3) || (pn == 4);
        const float qs = isq ? 0.125f * 1.4426950408889634f : 1.0f;
        float ssv[2][4];
#pragma unroll
        for (int ai = 0; ai < 2; ++ai)
#pragma unroll
            for (int m = 0; m < 4; ++m) ssv[ai][m] = ss[row0 + ai * HALF + m * 16];
        const bool rot0 = (pn <= 6) && ((wc & 1) == 0), rot1 = rot0 && (pn != 2);
        const bool act = fq < 2;
        f32x4 cs[2][4][2];
        if (rot0) {
#pragma unroll
            for (int ai = 0; ai < 2; ++ai)
#pragma unroll
                for (int m = 0; m < 4; ++m) { const float* rp = rope + (size_t)((row0 + ai * HALF + m * 16) & 4095) * 16 + 4 * (fq & 1);
                    cs[ai][m][0] = *(const f32x4*)(rp); cs[ai][m][1] = *(const f32x4*)(rp + 8); }
        }
#pragma unroll
        for (int ai = 0; ai < 2; ++ai) {
#pragma unroll
            for (int m = 0; m < 4; ++m) {
                const int row = row0 + ai * HALF + m * 16; const float rs = rstd_of(ssv[ai][m]) * qs;
#pragma unroll
                for (int bj = 0; bj < 2; ++bj) {
                    f32x4 v0 = acc[ai][bj][m][0] * rs, v1 = acc[ai][bj][m][1] * rs;
                    if ((bj == 0 ? rot0 : rot1) && act) { const f32x4 c = cs[ai][m][0], sn = cs[ai][m][1]; const f32x4 t0 = v0 * c - v1 * sn, t1 = v1 * c + v0 * sn; v0 = t0; v1 = t1; }
                    u32x4 w; w.x = cvt_pk_bf16(v0[0], v0[1]); w.y = cvt_pk_bf16(v0[2], v0[3]); w.z = cvt_pk_bf16(v1[0], v1[1]); w.w = cvt_pk_bf16(v1[2], v1[3]);
                    *(u32x4*)(P + (size_t)row * 2304 + col0 + bj * HALF) = w;
                }
            }
            asm volatile("" ::: "memory");
        }
    }
};
template <class Epi, class Sched, bool ALIGN_EPI = false, bool SP2 = false>
__device__ __forceinline__ void gemm_phase(PG8_LAS unsigned char* lds, const Gemm g, const Sched& S, const Epi& E, const int tid) {
    const int  wid = __builtin_amdgcn_readfirstlane(tid >> 6), lane = tid & 63, wr = wid >> 2, wc = wid & 3, fr = lane & 15, fq = lane >> 4;
    const int K = g.K, nt = K / BK;
    unsigned voffA[2], voffB[2];
#pragma unroll
    for (int i = 0; i < 2; ++i) { int R, C; stage_rc(tid * 16 + i * 8192, R, C); const int Rb = Epi::PERM ? ((R & ~31) + perm32(R & 31)) : R;
        voffA[i] = (unsigned)(R * (g.a_blocked ? BK : K) + C) * 2u; voffB[i] = (unsigned)(Rb * BK + C) * 2u; }
    const bool ablk = g.a_blocked != 0;
    const size_t kstepB = (size_t)BM * BK * 2, hstepB = (size_t)HALF * BK * 2, tstepB = (size_t)nt * BM * BK * 2;
    const size_t kstepA = ablk ? kstepB : (size_t)(BK * 2), hstepA = ablk ? hstepB : (size_t)HALF * K * 2, tstepA = ablk ? tstepB : (size_t)BM * K * 2;
    const unsigned ldsw = (unsigned)wid * 1024u;
    const int aoff = lds_byte(wr * 64 + fr, fq * 8), boff = lds_byte(wc * 32 + fr, fq * 8);
#define PG8_SA(b, h) (((b) * 2 + (h)) * HTB)
#define PG8_SB(b, h) ((4 + (b) * 2 + (h)) * HTB)
#define PG8_STAGE(bufoff, gbase, voff) do { _Pragma("unroll") for (int _i = 0; _i < 2; ++_i) \
        __builtin_amdgcn_global_load_lds((const unsigned*)((const char*)(gbase) + (voff)[_i]), (PG8_LAS unsigned*)(lds + (bufoff) + ldsw + _i * 8192), 16, 0, 0); } while (0)
#define PG8_LDA(dst, b, h) do { _Pragma("unroll") for (int m = 0; m < 4; ++m) _Pragma("unroll") for (int k = 0; k < 2; ++k) dst[m][k] = *(const PG8_LAS bf16x8*)(lds + PG8_SA(b, h) + aoff + m * 2048 + k * 1024); } while (0)
#define PG8_LDB(dst, b, h) do { _Pragma("unroll") for (int n = 0; n < 2; ++n) _Pragma("unroll") for (int k = 0; k < 2; ++k) dst[n][k] = *(const PG8_LAS bf16x8*)(lds + PG8_SB(b, h) + boff + n * 2048 + k * 1024); } while (0)
#define PG8_MMA(ai, bj, At, Bt) do { __builtin_amdgcn_s_setprio(1); _Pragma("unroll") for (int m = 0; m < 4; ++m) _Pragma("unroll") for (int n = 0; n < 2; ++n) _Pragma("unroll") for (int k = 0; k < 2; ++k) \
        acc[ai][bj][m][n] = __builtin_amdgcn_mfma_f32_16x16x32_bf16(Bt[n][k], At[m][k], acc[ai][bj][m][n], 0, 0, 0); __builtin_amdgcn_s_setprio(0); } while (0)
#define PG8_WAIT_V(n) asm volatile("s_waitcnt vmcnt(" #n ")" ::: "memory")
#define PG8_WAIT_L(n) asm volatile("s_waitcnt lgkmcnt(" #n ")" ::: "memory")
#define PG8_BAR __builtin_amdgcn_s_barrier()
#define PG8_SCHED __builtin_amdgcn_sched_barrier(0)
    Unit cur, nxt; int ui = 0;
    if (!S.next(0, cur)) return;
    f32x4 acc[2][2][4][2];
#pragma unroll
    for (int a = 0; a < 2; ++a)
#pragma unroll
        for (int b = 0; b < 2; ++b)
#pragma unroll
            for (int m = 0; m < 4; ++m)
#pragma unroll
                for (int n = 0; n < 2; ++n) acc[a][b][m][n] = (f32x4){0.f, 0.f, 0.f, 0.f};
    bf16x8 At[4][2], B0[2][2], B1[2][2];
    const char* cA = (const char*)g.A + (size_t)cur.pm * tstepA; const char* cB = (const char*)g.Bt + (size_t)cur.pn * tstepB;
    S.a_ready(cur);
    if constexpr (SP2) {
        PG8_STAGE(PG8_SB(0, 0), cB, voffB); PG8_STAGE(PG8_SB(0, 1), cB + hstepB, voffB); PG8_STAGE(PG8_SA(0, 0), cA, voffA); PG8_STAGE(PG8_SA(0, 1), cA + hstepA, voffA);
        if (wr == 1) PG8_BAR;
        PG8_WAIT_V(2); PG8_BAR;
        PG8_STAGE(PG8_SB(1, 0), cB + kstepB, voffB); PG8_STAGE(PG8_SA(1, 0), cA + kstepA, voffA); PG8_STAGE(PG8_SB(1, 1), cB + hstepB + kstepB, voffB);
        PG8_WAIT_V(6); PG8_BAR;
    } else {
        PG8_STAGE(PG8_SB(0, 0), cB, voffB); PG8_STAGE(PG8_SA(0, 0), cA, voffA); PG8_STAGE(PG8_SB(0, 1), cB + hstepB, voffB); PG8_STAGE(PG8_SA(0, 1), cA + hstepA, voffA);
        if (wr == 1) PG8_BAR;
        PG8_WAIT_V(4); PG8_BAR;
        PG8_STAGE(PG8_SB(1, 0), cB + kstepB, voffB); PG8_STAGE(PG8_SA(1, 0), cA + kstepA, voffA); PG8_STAGE(PG8_SB(1, 1), cB + hstepB + kstepB, voffB);
        PG8_WAIT_V(6); PG8_BAR;
    }
    for (;;) {
        const bool has_next = S.next(ui + 1, nxt);
        const char* nA = has_next ? (const char*)g.A + (size_t)nxt.pm * tstepA : cA; const char* nB = has_next ? (const char*)g.Bt + (size_t)nxt.pn * tstepB : cB;
        for (int t = 0; t < nt; t += 2) {
            const bool last = (t == nt - 2);
            const char* a1 = cA + (size_t)(t + 1) * kstepA;
            const char* a2 = last ? nA : cA + (size_t)(t + 2) * kstepA; const char* b2 = last ? nB : cB + (size_t)(t + 2) * kstepB;
            const char* a3 = a2 + kstepA; const char* b3 = b2 + kstepB;
            if (last && has_next) S.a_ready(nxt);
            if constexpr (SP2) {
            PG8_LDB(B0, 0, 0); PG8_LDB(B1, 0, 1); PG8_SCHED; PG8_LDA(At, 0, 0); PG8_STAGE(PG8_SA(1, 1), a1 + hstepA, voffA);
            PG8_WAIT_V(8); PG8_WAIT_L(0); PG8_BAR; PG8_MMA(0, 0, At, B0); PG8_MMA(0, 1, At, B1); PG8_BAR; PG8_SCHED;
            PG8_LDA(At, 0, 1); PG8_STAGE(PG8_SB(0, 0), b2, voffB); PG8_STAGE(PG8_SB(0, 1), b2 + hstepB, voffB); PG8_STAGE(PG8_SA(0, 0), a2, voffA);
            PG8_WAIT_V(8); PG8_WAIT_L(0); PG8_BAR; PG8_MMA(1, 0, At, B0); PG8_MMA(1, 1, At, B1); PG8_BAR; PG8_SCHED;
            PG8_LDB(B0, 1, 0); PG8_LDB(B1, 1, 1); PG8_SCHED; PG8_LDA(At, 1, 0); PG8_STAGE(PG8_SA(0, 1), a2 + hstepA, voffA);
            PG8_WAIT_V(8); PG8_WAIT_L(0); PG8_BAR; PG8_MMA(0, 0, At, B0); PG8_MMA(0, 1, At, B1); PG8_BAR; PG8_SCHED;
            PG8_LDA(At, 1, 1); PG8_STAGE(PG8_SB(1, 0), b3, voffB); PG8_STAGE(PG8_SB(1, 1), b3 + hstepB, voffB); PG8_STAGE(PG8_SA(1, 0), a3, voffA);
            PG8_WAIT_V(8); PG8_WAIT_L(0); PG8_BAR; PG8_MMA(1, 0, At, B0); PG8_MMA(1, 1, At, B1); PG8_BAR; PG8_SCHED;
            } else {
            PG8_LDB(B0, 0, 0); PG8_SCHED; PG8_LDA(At, 0, 0); PG8_STAGE(PG8_SA(1, 1), a1 + hstepA, voffA);
            PG8_WAIT_L(8); PG8_BAR; PG8_WAIT_L(0); PG8_MMA(0, 0, At, B0); PG8_BAR; PG8_SCHED;
            PG8_LDB(B1, 0, 1); PG8_STAGE(PG8_SB(0, 0), b2, voffB);
            PG8_BAR; PG8_WAIT_L(0); PG8_MMA(0, 1, At, B1); PG8_BAR;
            PG8_LDA(At, 0, 1); PG8_STAGE(PG8_SA(0, 0), a2, voffA);
            PG8_BAR; PG8_WAIT_L(0); PG8_MMA(1, 0, At, B0); PG8_BAR; PG8_SCHED;
            PG8_STAGE(PG8_SB(0, 1), b2 + hstepB, voffB);
            PG8_WAIT_V(6); PG8_BAR; PG8_MMA(1, 1, At, B1); PG8_BAR;
            PG8_LDB(B0, 1, 0); PG8_SCHED; PG8_LDA(At, 1, 0); PG8_STAGE(PG8_SA(0, 1), a2 + hstepA, voffA);
            PG8_WAIT_L(8); PG8_BAR; PG8_WAIT_L(0); PG8_MMA(0, 0, At, B0); PG8_BAR; PG8_SCHED;
            PG8_LDB(B1, 1, 1); PG8_STAGE(PG8_SB(1, 0), b3, voffB);
            PG8_BAR; PG8_WAIT_L(0); PG8_MMA(0, 1, At, B1); PG8_BAR;
            PG8_LDA(At, 1, 1); PG8_STAGE(PG8_SA(1, 0), a3, voffA);
            PG8_BAR; PG8_WAIT_L(0); PG8_MMA(1, 0, At, B0); PG8_BAR; PG8_SCHED;
            PG8_STAGE(PG8_SB(1, 1), b3 + hstepB, voffB);
            PG8_WAIT_V(6); PG8_BAR; PG8_MMA(1, 1, At, B1); PG8_BAR;
            }
        }
        if constexpr (ALIGN_EPI) { if (wr == 0) PG8_BAR; }
        if constexpr (!Epi::AFTER_DRAIN) { E(acc, cur, wr, wc, fr, fq); S.done(cur); }
        if (!has_next) break;
#pragma unroll
        for (int a = 0; a < 2; ++a)
#pragma unroll
            for (int b = 0; b < 2; ++b)
#pragma unroll
                for (int m = 0; m < 4; ++m)
#pragma unroll
                    for (int n = 0; n < 2; ++n) acc[a][b][m][n] = (f32x4){0.f, 0.f, 0.f, 0.f};
        cur = nxt; cA = nA; cB = nB; ++ui;
        if constexpr (ALIGN_EPI) { if (wr == 1) PG8_BAR; }
    }
    PG8_WAIT_V(0);
    if constexpr (!ALIGN_EPI) { if (wr == 0) PG8_BAR; }
    PG8_BAR;
    if constexpr (Epi::AFTER_DRAIN) { E.fused(acc, cur, wr, wc, fr, fq, lds, wid, lane); S.done(cur); }
#undef PG8_SA
#undef PG8_SB
#undef PG8_STAGE
#undef PG8_LDA
#undef PG8_LDB
#undef PG8_MMA
#undef PG8_WAIT_V
#undef PG8_WAIT_L
#undef PG8_BAR
#undef PG8_SCHED
}
}

namespace mk {
using pg8::bf16_t;
typedef short bf16x8 __attribute__((ext_vector_type(8)));
typedef short s16x4 __attribute__((ext_vector_type(4)));
typedef float f32x16 __attribute__((ext_vector_type(16)));
typedef float f32x4 __attribute__((ext_vector_type(4)));
typedef unsigned u32x4 __attribute__((ext_vector_type(4)));
#define MK_LAS __attribute__((address_space(3)))
constexpr int T = 98304, TP = 65536, D = 1024, FF = 2816, INW = 2304, SEQ = 4096;
constexpr int LDS_BYTES = 133120;
constexpr float INV0 = 1.000000000e+00f, INV1 = 1.939227447e-01f, INV2 = 3.760603093e-02f, INV3 = 7.292664737e-03f, INV4 = 1.414213562e-03f, INV5 = 2.742481757e-04f, INV6 = 5.318295897e-05f, INV7 = 1.031338538e-05f;
constexpr size_t OFF_BIG = 0;
constexpr size_t OFF_MERGED = (size_t)T * FF * 2;
constexpr size_t OFF_XB = OFF_MERGED + (size_t)T * D * 2;
constexpr size_t OFF_LSE = OFF_XB + (size_t)T * D * 2;
constexpr size_t OFF_W = OFF_LSE + (size_t)3 * T * 8 * 4;
constexpr size_t SZ_GU = (size_t)2 * FF * D * 2, SZ_DN = (size_t)D * FF * 2, SZ_IN = (size_t)INW * D * 2, SZ_OUT = (size_t)D * D * 2;
constexpr size_t OFF_GU1 = OFF_W, OFF_DN1 = OFF_GU1 + SZ_GU, OFF_GU2 = OFF_DN1 + SZ_DN, OFF_DN2 = OFF_GU2 + SZ_GU, OFF_WIN = OFF_DN2 + SZ_DN, OFF_WOUT = OFF_WIN + SZ_IN;
constexpr size_t OFF_SS = OFF_WOUT + SZ_OUT;
constexpr size_t OFF_ROPE = OFF_SS + (size_t)5 * T * 4;
constexpr size_t OFF_BAR = OFF_ROPE + (size_t)SEQ * 16 * 4;
constexpr size_t WS_END = OFF_BAR + 16384;

struct Args { const float* in[17]; float* out; unsigned char* ws; int ph_lo, ph_hi; };

__device__ __forceinline__ unsigned pk2(float lo, float hi) { return pg8::cvt_pk_bf16(lo, hi); }
__device__ __forceinline__ float wave_sum(float v) {
#pragma unroll
    for (int o = 1; o < 64; o <<= 1) v += __shfl_xor(v, o);
    return v;
}
#define MK_LDS_WAIT() asm volatile("s_waitcnt lgkmcnt(0)" ::: "memory")

__device__ __forceinline__ void p0_weight_item(const float* W0, const float* W1, int kind, int K, int Nsrc, const float* gain0, const float* gain1, bf16_t* WT, MK_LAS float* scr, int item, int nblk, int lane) {
    const int kb = item / nblk, nb = item % nblk, k0 = 64 * kb, n0 = 32 * nb;
    const int ng = lane & 7, kg = lane >> 3, R = n0 + 4 * ng;
    const float* src; int col;
    if (kind == 0) { const int n = (R >> 2) & 1; col = 128 * (R >> 8) + 32 * ((R >> 5) & 3) + 8 * ((R >> 3) & 3) + 4 * ((R >> 7) & 1); src = n ? W1 : W0; }
    else if (kind == 2) { const int hd = R >> 6, lc = R & 63; const bool qk = (hd < 10) || (hd >= 12 && hd < 28);
        col = (qk && lc < 16) ? (R & ~15) + ((lc >> 2) & 1) * 8 + ((lc >> 3) & 1) * 4 : R; src = W0; }
    else { col = R; src = W0; }
    f32x4 wv[8]; float gv[8];
#pragma unroll
    for (int i = 0; i < 8; ++i) { const int k = k0 + 8 * i + kg;
        wv[i] = *(const f32x4*)(src + (size_t)k * Nsrc + col);
        gv[i] = gain0 ? ((gain1 && k >= 512) ? gain1[k - 512] : gain0[k]) : 1.0f; }
#pragma unroll
    for (int i = 0; i < 8; ++i) { MK_LAS float* d = scr + (8 * i + kg) * 33 + 4 * ng;
        d[0] = wv[i][0] * gv[i]; d[1] = wv[i][1] * gv[i]; d[2] = wv[i][2] * gv[i]; d[3] = wv[i][3] * gv[i]; }
    MK_LDS_WAIT();
    const int c = lane & 7;
#pragma unroll
    for (int j = 0; j < 4; ++j) { const int n = (lane >> 3) + 8 * j; const MK_LAS float* s = scr + (8 * c) * 33 + n;
        u32x4 o; o.x = pk2(s[0 * 33], s[1 * 33]); o.y = pk2(s[2 * 33], s[3 * 33]); o.z = pk2(s[4 * 33], s[5 * 33]); o.w = pk2(s[6 * 33], s[7 * 33]);
        *(u32x4*)(WT + ((((size_t)((n0 + n) >> 8)) * (K >> 6) + (k0 >> 6)) * 256 + ((n0 + n) & 255)) * 64 + 8 * c) = o; }
    MK_LDS_WAIT();
}

__device__ __forceinline__ void phase_prologue(const Args& a, MK_LAS unsigned char* lds, int gw, int NGW, int wave, int lane) {
    MK_LAS float* scr = (MK_LAS float*)(lds + wave * 8448);
    unsigned char* ws = a.ws;
    constexpr int I_GU = (D / 64) * (2 * FF / 32), I_DN = (FF / 64) * (D / 32), I_IN = (D / 64) * (INW / 32), I_OUT = (D / 64) * (D / 32);
    constexpr int NITEMS = 2 * I_GU + 2 * I_DN + I_IN + I_OUT;
    for (int it = gw; it < NITEMS; it += NGW) {
        int r = it; const float *W0, *W1 = nullptr, *g0 = nullptr, *g1 = nullptr; int kind = 1, K = D, Nsrc = D; size_t woff;
        if (r < 2 * I_GU) { const bool s2 = r >= I_GU; r -= s2 ? I_GU : 0; W0 = a.in[s2 ? 13 : 3]; W1 = a.in[s2 ? 14 : 4]; g0 = a.in[s2 ? 12 : 2]; kind = 0; Nsrc = FF; woff = s2 ? OFF_GU2 : OFF_GU1; }
        else if (r < 2 * I_GU + 2 * I_DN) { r -= 2 * I_GU; const bool s2 = r >= I_DN; r -= s2 ? I_DN : 0; W0 = a.in[s2 ? 15 : 5]; K = FF; woff = s2 ? OFF_DN2 : OFF_DN1; }
        else if (r < 2 * I_GU + 2 * I_DN + I_IN) { r -= 2 * I_GU + 2 * I_DN; W0 = a.in[7]; g0 = a.in[6]; Nsrc = INW; kind = 2; woff = OFF_WIN; }
        else { r -= 2 * I_GU + 2 * I_DN + I_IN; W0 = a.in[11]; g0 = a.in[9]; g1 = a.in[10]; woff = OFF_WOUT; }
        const int nblk = (kind == 0 ? 2 * FF : Nsrc) / 32;
        p0_weight_item(W0, W1, kind, K, Nsrc, g0, g1, (bf16_t*)(ws + woff), scr, r, nblk, lane);
    }
    bf16_t* xb = (bf16_t*)(ws + OFF_XB); float* ss = (float*)(ws + OFF_SS);
    constexpr int RB = 4;
    for (int row0 = gw * RB; row0 < T; row0 += NGW * RB) {
        f32x4 v[RB][4];
#pragma unroll
        for (int q = 0; q < RB; ++q) { const int row = row0 + q; const float* xr = row < TP ? a.in[0] + (size_t)row * D : a.in[1] + (size_t)(row - TP) * D;
#pragma unroll
            for (int j = 0; j < 2; ++j) { v[q][2 * j] = *(const f32x4*)(xr + j * 512 + lane * 8); v[q][2 * j + 1] = *(const f32x4*)(xr + j * 512 + lane * 8 + 4); } }
#pragma unroll
        for (int q = 0; q < RB; ++q) { const int row = row0 + q; float s = 0.f;
#pragma unroll
            for (int j = 0; j < 2; ++j) { const f32x4 v0 = v[q][2 * j], v1 = v[q][2 * j + 1];
                s += (v0[0] * v0[0] + v0[1] * v0[1]) + (v0[2] * v0[2] + v0[3] * v0[3]) + (v1[0] * v1[0] + v1[1] * v1[1]) + (v1[2] * v1[2] + v1[3] * v1[3]);
                u32x4 w; w.x = pk2(v0[0], v0[1]); w.y = pk2(v0[2], v0[3]); w.z = pk2(v1[0], v1[1]); w.w = pk2(v1[2], v1[3]);
                *(u32x4*)(xb + pg8::blk1024(row, j * 512 + lane * 8)) = w; }
            s = wave_sum(s);
            if (lane == 0) { ss[row] = s; ss[T + row] = 0.f; ss[2 * T + row] = 0.f; ss[3 * T + row] = 0.f; } }
    }
    float* rope = (float*)(ws + OFF_ROPE);
    for (int i = gw * 64 + lane; i < SEQ * 8; i += NGW * 64) {
        const int pos = i >> 3, j = i & 7;
        const float inv = j == 0 ? INV0 : j == 1 ? INV1 : j == 2 ? INV2 : j == 3 ? INV3 : j == 4 ? INV4 : j == 5 ? INV5 : j == 6 ? INV6 : INV7;
        const float ang = (float)pos * inv;
        double tr = (double)ang * 0.15915494309189535; tr -= __builtin_floor(tr);
        const float fr = (float)tr;
        rope[pos * 16 + j] = __builtin_amdgcn_cosf(fr); rope[pos * 16 + 8 + j] = __builtin_amdgcn_sinf(fr);
    }
}

__device__ __forceinline__ int crow(int r, int hi) { return (r & 3) + 8 * (r >> 2) + 4 * hi; }
typedef short v4i16_t __attribute__((ext_vector_type(4)));
__device__ __forceinline__ s16x4 vtr(const MK_LAS unsigned char* p) { return __builtin_bit_cast(s16x4, __builtin_amdgcn_ds_read_tr16_b64_v4i16((MK_LAS v4i16_t*)p)); }
#define MK_MFMA32(a, b, c) __builtin_amdgcn_mfma_f32_32x32x16_bf16(a, b, c, 0, 0, 0)
constexpr int ATT_NK = 384, ATT_KCS = (ATT_NK + 2) * 16  , ATT_VOFF = 49408, ATT_VDS = ATT_NK * 64 + 128  , ATT_WOFF = ATT_VOFF + 2 * ATT_VDS, ATT_WSZ = 4224;
static_assert(8 * ATT_KCS <= ATT_VOFF && ATT_WOFF + 8 * ATT_WSZ <= LDS_BYTES, "attention LDS map");
constexpr float ATT_THR = 8.0f;
#define MK_WAIT_BAR() asm volatile("s_waitcnt lgkmcnt(0)\n\ts_barrier" ::: "memory")

struct AttItem {
    size_t rowbase;
    int qcol, kcol, vcol;
    int stride, res, hw, L;
    int kb0, NK;
    int q0;
    int isA;
    bf16_t* out; int out_ld, out_col;
    float* lse;
};
__device__ __forceinline__ void att_decode(const Args& a, int id, AttItem& I) {
    unsigned char* ws = a.ws;
    bf16_t* merged = (bf16_t*)(ws + OFF_MERGED);
    constexpr int NA = 24 * 2 * 64;
    if (id < NA) {
        const int n = id >> 7, kvh = (id >> 6) & 1, qb = id & 63;
        I.rowbase = (size_t)n * SEQ; I.qcol = kvh * 256; I.kcol = 512 + kvh * 64; I.vcol = 640 + kvh * 64;
        I.stride = 1; I.res = 0; I.hw = 128; I.L = SEQ; I.kb0 = 64 * qb - 128; I.NK = 320; I.q0 = 64 * qb; I.isA = 1;
        I.out = merged; I.out_ld = 1024; I.out_col = kvh * 256; I.lse = nullptr;
    } else {
        const int idb = id - NA; const int n = idb / 384, rem = idb - n * 384, h = rem / 48, k = rem - h * 48, g = k >> 4, f = k & 15;
        const int sh = 2 * g, dd = 1 << sh, c = f >> sh;
        I.rowbase = (size_t)n * SEQ; I.qcol = 768 + h * 64; I.kcol = 1280 + h * 64; I.vcol = 1792 + h * 64;
        I.stride = dd; I.res = f & (dd - 1); I.hw = 64; I.L = SEQ >> sh; I.kb0 = 256 * c - 64; I.NK = 384; I.q0 = 256 * c; I.isA = 0;
        if (g == 0) { I.out = merged; I.out_ld = 1024; I.out_col = 512 + h * 64; }
        else { I.out = (bf16_t*)a.out + (size_t)(g - 1) * T * 512; I.out_ld = 512; I.out_col = h * 64; }
        I.lse = (float*)(ws + OFF_LSE) + (size_t)g * T * 8 + h;
    }
}
__device__ __forceinline__ void att_prefetch(const bf16_t* __restrict__ proj, const AttItem& I, int tid, int wave, u32x4 (&kr)[6], u32x4 (&vr)[6], bf16x8 (&qr)[4]) {
    const size_t tokstride = (size_t)I.stride * INW;
    {
        const int lane = tid & 63, r32 = lane & 31, hi = lane >> 5;
        const int hsel = I.isA ? (wave & 3) : 0, t0 = I.q0 + 32 * (I.isA ? (wave >> 2) : wave);
        const bf16_t* qp = proj + (I.rowbase + I.res) * INW + (size_t)(t0 + r32) * tokstride + I.qcol + hsel * 64 + hi * 8;
#pragma unroll
        for (int d0 = 0; d0 < 4; ++d0) qr[d0] = *(const bf16x8*)(qp + d0 * 16);
    }
    const bf16_t* seq0 = proj + (I.rowbase + I.res) * INW + (tid & 7) * 8;
#pragma unroll
    for (int i = 0; i < 6; ++i) {
        const int row = i * 64 + (tid >> 3), key = I.kb0 + row;
        if (row < I.NK && key >= 0 && key < I.L) { const bf16_t* p = seq0 + (size_t)key * tokstride; kr[i] = *(const u32x4*)(p + I.kcol); vr[i] = *(const u32x4*)(p + I.vcol); }
        else { kr[i] = (u32x4){0u, 0u, 0u, 0u}; vr[i] = (u32x4){0u, 0u, 0u, 0u}; }
    }
}
__device__ __forceinline__ void att_store(MK_LAS unsigned char* lds, int tid, const u32x4 (&kr)[6], const u32x4 (&vr)[6]) {
    const int chunk = tid & 7;
    MK_LAS unsigned char* kp = lds + chunk * ATT_KCS + (tid >> 3) * 16;
    MK_LAS unsigned char* vp = lds + ATT_VOFF + (chunk >> 2) * ATT_VDS + (tid >> 3) * 64 + (chunk & 3) * 16;
#pragma unroll
    for (int i = 0; i < 6; ++i) { *(MK_LAS u32x4*)(kp + i * 64 * 16) = kr[i]; *(MK_LAS u32x4*)(vp + i * 64 * 64) = vr[i]; }
}

struct AttPend { bf16_t* p; size_t step; float* lsep; float lsev; int valid; };
__device__ __forceinline__ void att_flush(const AttPend& P, MK_LAS unsigned char* lds, int wave, int lane) {
    if (!P.valid) return;
    const MK_LAS bf16_t* stg = (const MK_LAS bf16_t*)(lds + ATT_WOFF + wave * ATT_WSZ);
#pragma unroll
    for (int i = 0; i < 4; ++i) { const int row = i * 8 + (lane >> 3), ch = lane & 7; *(u32x4*)(P.p + i * P.step) = *(const MK_LAS u32x4*)(stg + row * 64 + ch * 8); }
    if (P.lsep) *P.lsep = P.lsev;
}
__device__ __forceinline__ void att_compute(const AttItem& I, MK_LAS unsigned char* lds, int wave, int lane, const bf16x8 (&qr)[4], const float sink_l2, const bool do_store, AttPend& P) {
    const int r32 = lane & 31, hi = lane >> 5;
    MK_LAS unsigned char* wl = lds + ATT_WOFF + wave * ATT_WSZ;
    MK_LAS float* wsf = (MK_LAS float*)(wl + 4096);
    const int hsel = I.isA ? (wave & 3) : 0;
    const int t0 = I.q0 + 32 * (I.isA ? (wave >> 2) : wave);
    const int ocol = I.out_col + hsel * 64;
    const int nkt = I.hw / 16 + 1;
    const int kt_lo = t0 >= I.hw ? 0 : ((I.hw - t0) >> 5);
    int kt_hi = (I.L - t0 + I.hw) >> 5; kt_hi = kt_hi < nkt ? kt_hi : nkt;
    const MK_LAS unsigned char* kfb = lds + hi * ATT_KCS + r32 * 16;
    const MK_LAS unsigned char* vfb = lds + ATT_VOFF + ((lane >> 4) & 1) * 32 + (lane & 3) * 8 + (4 * hi + ((lane & 15) >> 2)) * 64;
    float mhat = -1.0e4f, lsum = 0.f;
    f32x16 o0 = {}, o1 = {};
    for (int kt = kt_lo; kt < kt_hi; ++kt) {
        const int krow0 = t0 - I.hw + 32 * kt - I.kb0;
        const MK_LAS unsigned char* kp = kfb + krow0 * 16;
        bf16x8 kf[4];
#pragma unroll
        for (int d0 = 0; d0 < 4; ++d0) kf[d0] = *(const MK_LAS bf16x8*)(kp + 2 * d0 * ATT_KCS);
        const MK_LAS unsigned char* vp = vfb + krow0 * 64;
#define MK_VFR(off) __builtin_shufflevector(vtr(vp + (off)), vtr(vp + (off) + 512), 0, 1, 2, 3, 4, 5, 6, 7)
        const bf16x8 v00 = MK_VFR(0), v01 = MK_VFR(ATT_VDS), v10 = MK_VFR(1024), v11 = MK_VFR(ATT_VDS + 1024);
#undef MK_VFR
        f32x16 p = {};
#pragma unroll
        for (int d0 = 0; d0 < 4; ++d0) p = MK_MFMA32(kf[d0], qr[d0], p);
        if (kt == 0) {
#pragma unroll
            for (int r = 0; r < 16; ++r) if (crow(r, hi) < r32) p[r] = -1.0e30f;
        }
        if (kt == nkt - 1) {
#pragma unroll
            for (int r = 0; r < 16; ++r) if (crow(r, hi) > r32) p[r] = -1.0e30f;
        }
        float rm = __builtin_fmaxf(p[0], p[1]);
#pragma unroll
        for (int r = 2; r < 16; ++r) rm = __builtin_fmaxf(rm, p[r]);
        rm = __builtin_fmaxf(rm, __shfl_xor(rm, 32));
        if (__any(rm > mhat + ATT_THR)) {
            const float mnew = __builtin_fmaxf(mhat, rm), f = __builtin_amdgcn_exp2f(mhat - mnew);
            lsum *= f; mhat = mnew;
            if (hi == 0) wsf[r32] = f;
            MK_LDS_WAIT();
#pragma unroll
            for (int g = 0; g < 4; ++g) { const f32x4 w4 = *(const MK_LAS f32x4*)(wsf + 8 * g + 4 * hi);
#pragma unroll
                for (int j = 0; j < 4; ++j) { o0[4 * g + j] *= w4[j]; o1[4 * g + j] *= w4[j]; } }
            MK_LDS_WAIT();
        }
        float sacc = 0.f;
#pragma unroll
        for (int r = 0; r < 16; ++r) { p[r] = __builtin_amdgcn_exp2f(p[r] - mhat); sacc += p[r]; }
        lsum += sacc;
        u32x4 pw0, pw1;
        pw0.x = pk2(p[0], p[1]); pw0.y = pk2(p[2], p[3]); pw0.z = pk2(p[4], p[5]); pw0.w = pk2(p[6], p[7]);
        pw1.x = pk2(p[8], p[9]); pw1.y = pk2(p[10], p[11]); pw1.z = pk2(p[12], p[13]); pw1.w = pk2(p[14], p[15]);
        o0 = MK_MFMA32(__builtin_bit_cast(bf16x8, pw0), v00, o0); o1 = MK_MFMA32(__builtin_bit_cast(bf16x8, pw0), v01, o1);
        o0 = MK_MFMA32(__builtin_bit_cast(bf16x8, pw1), v10, o0); o1 = MK_MFMA32(__builtin_bit_cast(bf16x8, pw1), v11, o1);
    }
    float ltot = lsum + __shfl_xor(lsum, 32);
    if (I.isA) ltot += __builtin_amdgcn_exp2f(sink_l2 - mhat);
    const float rl = 1.0f / ltot;
    if (hi == 0) wsf[r32] = rl;
    MK_LDS_WAIT();
    MK_LAS bf16_t* stg = (MK_LAS bf16_t*)wl;
#pragma unroll
    for (int g = 0; g < 4; ++g) { const f32x4 w4 = *(const MK_LAS f32x4*)(wsf + 8 * g + 4 * hi);
#pragma unroll
        for (int j = 0; j < 4; ++j) { const int r = 4 * g + j, orow = crow(r, hi);
            stg[orow * 64 + r32] = (bf16_t)(pk2(o0[r] * w4[j], 0.f) & 0xffffu); stg[orow * 64 + 32 + r32] = (bf16_t)(pk2(o1[r] * w4[j], 0.f) & 0xffffu); } }
    MK_LDS_WAIT();
    P.valid = do_store ? 1 : 0;
    P.p = I.out + (I.rowbase + I.res + (size_t)I.stride * (t0 + (lane >> 3))) * I.out_ld + ocol + (lane & 7) * 8;
    P.step = (size_t)8 * I.stride * I.out_ld;
    P.lsep = (I.lse && hi == 0) ? I.lse + (I.rowbase + I.res + (size_t)I.stride * (t0 + r32)) * 8 : nullptr;
    P.lsev = mhat + __builtin_log2f(ltot);
}

__device__ __forceinline__ void phase_attention(const Args& a, MK_LAS unsigned char* lds, int vcu, int G, int tid, int wave, int lane, const int mode) {
    const bf16_t* proj = (const bf16_t*)(a.ws + OFF_BIG);
    constexpr int NITEMS = 24 * 2 * 64 + 24 * 8 * 48;
    u32x4 kr[6], vr[6]; bf16x8 qn[4];
    int id = vcu;
    AttItem I;
#pragma unroll
    for (int i = 0; i < 6; ++i) { kr[i] = (u32x4){0u, 0u, 0u, 0u}; vr[i] = kr[i]; }
#pragma unroll
    for (int i = 0; i < 4; ++i) qn[i] = (bf16x8){0, 0, 0, 0, 0, 0, 0, 0};
    AttPend P; P.valid = 0; P.p = nullptr; P.step = 0; P.lsep = nullptr; P.lsev = 0.f;
    const float sinkA = a.in[8][wave & 3] * 1.4426950408889634f, sinkB = a.in[8][4 + (wave & 3)] * 1.4426950408889634f;
    if (id < NITEMS) { att_decode(a, id, I); if (mode != 1) att_prefetch(proj, I, tid, wave, kr, vr, qn); }
    while (id < NITEMS) {
        if (mode != 1) att_store(lds, tid, kr, vr);
        att_flush(P, lds, wave, lane);
        bf16x8 qr[4];
#pragma unroll
        for (int d0 = 0; d0 < 4; ++d0) qr[d0] = qn[d0];
        MK_WAIT_BAR();
        const int nid = id + G;
        if (nid < NITEMS && mode != 1) { AttItem N; att_decode(a, nid, N); att_prefetch(proj, N, tid, wave, kr, vr, qn); }
        if (mode != 2) att_compute(I, lds, wave, lane, qr, (I.qcol >> 8) ? sinkB : sinkA, mode == 0, P);
        MK_WAIT_BAR();
        id = nid;
        if (id < NITEMS) att_decode(a, id, I);
    }
    att_flush(P, lds, wave, lane);
}

__device__ __forceinline__ void unpack8(const u32x4 w, float (&v)[8]) {
    v[0] = __uint_as_float(w.x << 16); v[1] = __uint_as_float(w.x & 0xffff0000u); v[2] = __uint_as_float(w.y << 16); v[3] = __uint_as_float(w.y & 0xffff0000u);
    v[4] = __uint_as_float(w.z << 16); v[5] = __uint_as_float(w.z & 0xffff0000u); v[6] = __uint_as_float(w.w << 16); v[7] = __uint_as_float(w.w & 0xffff0000u);
}
__device__ __forceinline__ u32x4 pack8(const float (&v)[8], float s) { u32x4 w; w.x = pk2(v[0] * s, v[1] * s); w.y = pk2(v[2] * s, v[3] * s); w.z = pk2(v[4] * s, v[5] * s); w.w = pk2(v[6] * s, v[7] * s); return w; }
__device__ __forceinline__ void phase_finalize(const Args& a, int gw, int NGW, int lane) {
    unsigned char* ws = a.ws;
    bf16_t* merged = (bf16_t*)(ws + OFF_MERGED); const bf16_t* ob2 = (const bf16_t*)a.out; const bf16_t* ob3 = ob2 + (size_t)T * 512; const float* lse = (const float*)(ws + OFF_LSE);
    const int h = lane >> 3;
    constexpr int RB = 4;
    for (int row0 = gw * RB; row0 < T; row0 += NGW * RB) {
        u32x4 wa[RB], w1[RB], w2[RB], w3[RB]; float l1[RB], l2[RB], l3[RB];
#pragma unroll
        for (int q = 0; q < RB; ++q) { const size_t row = row0 + q; const bf16_t* mr = merged + row * 1024;
            wa[q] = *(const u32x4*)(mr + lane * 8); w1[q] = *(const u32x4*)(mr + 512 + lane * 8);
            w2[q] = *(const u32x4*)(ob2 + row * 512 + lane * 8); w3[q] = *(const u32x4*)(ob3 + row * 512 + lane * 8);
            l1[q] = lse[row * 8 + h]; l2[q] = lse[(size_t)T * 8 + row * 8 + h]; l3[q] = lse[(size_t)2 * T * 8 + row * 8 + h]; }
#pragma unroll
        for (int q = 0; q < RB; ++q) { bf16_t* mr = merged + (size_t)(row0 + q) * 1024;
            float va[8], b1[8], b2[8], b3[8];
            unpack8(wa[q], va); unpack8(w1[q], b1); unpack8(w2[q], b2); unpack8(w3[q], b3);
            const float mx = __builtin_fmaxf(l1[q], __builtin_fmaxf(l2[q], l3[q]));
            const float e1 = __builtin_amdgcn_exp2f(l1[q] - mx), e2 = __builtin_amdgcn_exp2f(l2[q] - mx), e3 = __builtin_amdgcn_exp2f(l3[q] - mx), ri = 1.0f / (e1 + e2 + e3);
            const float c1 = e1 * ri, c2 = e2 * ri, c3 = e3 * ri;
            float sa = 0.f, sb = 0.f;
#pragma unroll
            for (int j = 0; j < 8; ++j) { b1[j] = c1 * b1[j] + c2 * b2[j] + c3 * b3[j]; sa += va[j] * va[j]; sb += b1[j] * b1[j]; }
            sa = wave_sum(sa); sb = wave_sum(sb);
            const float ra = __builtin_amdgcn_rsqf(sa * (1.0f / 512.0f) + 1e-6f), rb = __builtin_amdgcn_rsqf(sb * (1.0f / 512.0f) + 1e-6f);
            *(u32x4*)(mr + lane * 8) = pack8(va, ra);
            *(u32x4*)(mr + 512 + lane * 8) = pack8(b1, rb); }
    }
}

__device__ __forceinline__ void phase_final_norm(const Args& a, int gw, int NGW, int lane) {
    const float* ss = (const float*)(a.ws + OFF_SS) + (size_t)3 * T; const float* gain = a.in[16]; const bf16_t* xb = (const bf16_t*)(a.ws + OFF_XB);
    f32x4 g[4];
#pragma unroll
    for (int j = 0; j < 2; ++j) { g[2 * j] = *(const f32x4*)(gain + j * 512 + lane * 8); g[2 * j + 1] = *(const f32x4*)(gain + j * 512 + lane * 8 + 4); }
    constexpr int RB = 8;
    for (int row0 = gw * RB; row0 < T; row0 += NGW * RB) {
        u32x4 v[RB][2]; float rs[RB];
#pragma unroll
        for (int q = 0; q < RB; ++q) { rs[q] = ss[row0 + q];
#pragma unroll
            for (int j = 0; j < 2; ++j) v[q][j] = *(const u32x4*)(xb + pg8::blk1024(row0 + q, j * 512 + lane * 8)); }
#pragma unroll
        for (int q = 0; q < RB; ++q) { float* xr = a.out + (size_t)(row0 + q) * D; const float r = pg8::rstd_of(rs[q]);
#pragma unroll
            for (int j = 0; j < 2; ++j) { float f[8]; unpack8(v[q][j], f);
                const f32x4 o0 = (f32x4){f[0], f[1], f[2], f[3]} * r * g[2 * j], o1 = (f32x4){f[4], f[5], f[6], f[7]} * r * g[2 * j + 1];
                *(f32x4*)(xr + j * 512 + lane * 8) = o0; *(f32x4*)(xr + j * 512 + lane * 8 + 4) = o1; } }
    }
}


#define XB_TMO      128
#define XB_XCNT(j)  (256  + 64 * (j))
#define XB_XSUB(j)  (1280 + 64 * (j))
#define XB_XGEN(j)  (2304 + 64 * (j))
#define XB_TOP      3328
#define XB_TOPGEN   3392
#define XCD_BAR_WORDS 3456
#define XB_SPIN_CAP (1u << 18)
__device__ __forceinline__ unsigned xb_ld(unsigned* p)              { return __hip_atomic_load(p, __ATOMIC_RELAXED, __HIP_MEMORY_SCOPE_AGENT); }
__device__ __forceinline__ unsigned xb_add(unsigned* p, unsigned v) { return __hip_atomic_fetch_add(p, v, __ATOMIC_RELAXED, __HIP_MEMORY_SCOPE_AGENT); }
__device__ __forceinline__ unsigned xb_xcc_id() { return (unsigned)__builtin_amdgcn_s_getreg((3 << 11) | 20) & 0xFu; }
#define XB_SPIN(cond, bar) do { unsigned _sp = 0; while (cond) { __builtin_amdgcn_s_sleep(1); \
    if ((++_sp & 255u) == 0u) { if (xb_ld(&(bar)[XB_TMO])) break; if (_sp > XB_SPIN_CAP) { atomicAdd(&(bar)[XB_TMO], 1u); break; } } } } while (0)
struct XcdBarrier { unsigned* bar; unsigned x; volatile MK_LAS unsigned* st; };
__device__ __forceinline__ void xcd_barrier_complete(unsigned* bar, unsigned x, unsigned& nloc, unsigned& nx) {
    const unsigned G = gridDim.x * gridDim.y * gridDim.z;
    unsigned sum, cnt, mine, sp = 0u;
    for (;;) {
        sum = 0u; cnt = 0u; mine = 0u;
#pragma unroll
        for (unsigned j = 0; j < 16; ++j) { const unsigned c = xb_ld(&bar[XB_XCNT(j)]); sum += c; cnt += (c > 0u) ? 1u : 0u; mine = (j == x) ? c : mine; }
        if (sum == G) break;
        __builtin_amdgcn_s_sleep(1);
        if ((++sp & 255u) == 0u) { if (xb_ld(&bar[XB_TMO])) break; if (sp > XB_SPIN_CAP) { atomicAdd(&bar[XB_TMO], 1u); break; } }
    }
    nloc = mine > 0u ? mine : 1u; nx = cnt > 0u ? cnt : 1u;
}
__device__ __forceinline__ void xcd_barrier(const XcdBarrier& b) {
    asm volatile("s_waitcnt vmcnt(0)" ::: "memory");
    __syncthreads();
    if (threadIdx.x == 0) {
        unsigned* bar = b.bar;
        __builtin_amdgcn_s_waitcnt(0);
        unsigned nloc = b.st[0], nx = b.st[1];
        if (nloc == 0u) { xcd_barrier_complete(bar, b.x, nloc, nx); b.st[0] = nloc; b.st[1] = nx; }
        const unsigned old = xb_add(&bar[XB_XSUB(b.x)], 1u);
        const unsigned gen = old / nloc;
        if (old + 1u == (gen + 1u) * nloc) {
            __builtin_amdgcn_fence(__ATOMIC_RELEASE, "agent");
            asm volatile("s_waitcnt vmcnt(0)" ::: "memory");
            const unsigned og = xb_add(&bar[XB_TOP], 1u);
            const unsigned tg = og / nx;
            if (og + 1u == (tg + 1u) * nx) xb_add(&bar[XB_TOPGEN], 1u);
            else XB_SPIN(xb_ld(&bar[XB_TOPGEN]) == tg, bar);
            __builtin_amdgcn_fence(__ATOMIC_ACQUIRE, "agent");
            xb_add(&bar[XB_XGEN(b.x)], 1u);
            asm volatile("s_waitcnt vmcnt(0)" ::: "memory");
        } else {
            XB_SPIN(xb_ld(&bar[XB_XGEN(b.x)]) == gen, bar);
            __builtin_amdgcn_fence(__ATOMIC_ACQUIRE, "agent");
            asm volatile("s_waitcnt vmcnt(0)" ::: "memory");
        }
    }
    __syncthreads();
}

constexpr int NPHASE = 10;
#ifndef MK_STAG_GU
#define MK_STAG_GU 0
#endif
__device__ __forceinline__ void mk_stagger(int bid, int ticks) {
    const int g = (bid >> 3) & 7;
    if (ticks > 0 && g) { const unsigned long long t0 = __builtin_amdgcn_s_memrealtime(), w = (unsigned long long)(g * ticks);
        while (__builtin_amdgcn_s_memrealtime() - t0 < w) __builtin_amdgcn_s_sleep(4); }
}
#ifndef MK_MASK
#define MK_MASK 0x3ff
#endif
#define MK_ON(p) ((MK_MASK >> (p)) & 1)
__global__ __launch_bounds__(512) void mk_fwd(const Args a) {
    extern __shared__ __attribute__((aligned(16))) unsigned char lds_raw[];
    MK_LAS unsigned char* lds = (MK_LAS unsigned char*)lds_raw;
    cg::grid_group grid = cg::this_grid();
    volatile MK_LAS unsigned* xst = (volatile MK_LAS unsigned*)(lds + LDS_BYTES - 16);
    if (threadIdx.x == 0) { xst[0] = 0u; xst[1] = 0u; (void)xb_add(&((unsigned*)(a.ws + OFF_BAR))[XB_XCNT(xb_xcc_id())], 1u); }
    __syncthreads();
#ifndef MK_REP
#define MK_REP 0
#endif
#ifndef MK_GU_PROBE
#define MK_GU_PROBE 1
#endif
#ifndef MK_ATT_PROBE
#define MK_ATT_PROBE 0
#endif
    for (int ph2 = a.ph_lo * 2; ph2 < a.ph_hi * 2; ++ph2) {
        const int ph = ph2 >> 1;
        if ((ph2 & 1) && !((MK_REP >> ph) & 1)) continue;
        if (ph2 > a.ph_lo * 2) {
            if (ph2 == a.ph_lo * 2 + 2) grid.sync();
            else { XcdBarrier xb; xb.bar = (unsigned*)(a.ws + OFF_BAR); xb.x = xb_xcc_id(); xb.st = xst; xcd_barrier(xb); }
        }
        int tid = threadIdx.x; asm volatile("" : "+v"(tid));
        const int lane = tid & 63, wave = __builtin_amdgcn_readfirstlane(tid >> 6);
        int G = gridDim.x, bid = blockIdx.x; asm volatile("" : "+s"(G), "+s"(bid));
        const int vcu = (bid & 7) * (G >> 3) + (bid >> 3);
        const int gw = vcu * 8 + wave, NGW = G * 8;
        size_t wzero = 0; asm volatile("" : "+s"(wzero)); unsigned char* ws = a.ws + wzero;
        float* ss = (float*)(ws + OFF_SS);
        if (MK_ON(0) && ph == 0) phase_prologue(a, lds, gw, NGW, wave, lane);
        else if (MK_ON(1) && (ph == 1 || ph == 7)) {
            const bool second = ph == 7;
            mk_stagger(bid, MK_STAG_GU);
            pg8::Gemm g; g.A = (const bf16_t*)(ws + OFF_XB); g.Bt = (const bf16_t*)(ws + (second ? OFF_GU2 : OFF_GU1)); g.M = T; g.N = 2 * FF; g.K = D; g.a_blocked = 1;
            pg8::StaticOrder S; S.init(T, 2 * FF, G, bid);
            pg8::EpiGateUp E; E.H = (bf16_t*)(ws + OFF_BIG); E.ss = ss + (second ? 2 * (size_t)T : 0); E.enabled = (ph2 & 1) ? MK_GU_PROBE : 1;
            pg8::gemm_phase<pg8::EpiGateUp, pg8::StaticOrder, true, true>(lds, g, S, E, tid);
        } else if (MK_ON(2) && (ph == 2 || ph == 6 || ph == 8)) {
            pg8::Gemm g; pg8::EpiResid E; E.split = TP; E.res_lo = a.in[0]; E.res_hi = a.in[1]; E.xb = (bf16_t*)(ws + OFF_XB);
            if (ph == 2) { g.A = (const bf16_t*)(ws + OFF_BIG); g.Bt = (const bf16_t*)(ws + OFF_DN1); g.K = FF; E.out = nullptr; E.res_bf16 = 0; E.write_xb = 1; E.ssout = ss + T; E.alpha = 0.5f; }
            else if (ph == 6) { g.A = (const bf16_t*)(ws + OFF_MERGED); g.Bt = (const bf16_t*)(ws + OFF_WOUT); g.K = D; E.out = nullptr; E.res_bf16 = 1; E.write_xb = 1; E.ssout = ss + 2 * (size_t)T; E.alpha = 1.0f; }
            else { g.A = (const bf16_t*)(ws + OFF_BIG); g.Bt = (const bf16_t*)(ws + OFF_DN2); g.K = FF; E.out = nullptr; E.res_bf16 = 1; E.write_xb = 1; E.ssout = ss + 3 * (size_t)T; E.alpha = 0.5f; }
            g.M = T; g.N = D; g.a_blocked = (ph == 6) ? 0 : 1;
            pg8::StaticOrder S; S.init(T, D, G, bid);
            pg8::gemm_phase<pg8::EpiResid, pg8::StaticOrder, true, true>(lds, g, S, E, tid);
        } else if (MK_ON(3) && ph == 3) {
            pg8::Gemm g; g.A = (const bf16_t*)(ws + OFF_XB); g.Bt = (const bf16_t*)(ws + OFF_WIN); g.M = T; g.N = INW; g.K = D; g.a_blocked = 1;
            pg8::StaticOrder S; S.init(T, INW, G, bid);
            pg8::EpiQkv E; E.P = (bf16_t*)(ws + OFF_BIG); E.ss = ss + T; E.rope = (const float*)(ws + OFF_ROPE);
            pg8::gemm_phase<pg8::EpiQkv, pg8::StaticOrder, true, true>(lds, g, S, E, tid);
        } else if (MK_ON(4) && ph == 4) phase_attention(a, lds, vcu, G, tid, wave, lane, (ph2 & 1) ? MK_ATT_PROBE : 0);
        else if (MK_ON(5) && ph == 5) phase_finalize(a, gw, NGW, lane);
        else if (MK_ON(9) && ph == 9) phase_final_norm(a, gw, NGW, lane);
    }
}
}

#ifndef MK_N_LAUNCHES
#define MK_N_LAUNCHES 1
#endif
extern "C" void kernel_launch(void* const* d_in, const int* in_sizes, int n_in, void* d_out, int out_size, void* d_ws, size_t ws_size, hipStream_t stream) {
    static int grid = 0;
    if (grid == 0) {
        if (n_in != 17 || out_size != mk::T * mk::D || ws_size < mk::WS_END) { fprintf(stderr, "kernel_launch: unexpected shapes (n_in %d out %d ws %zu need %zu)\n", n_in, out_size, ws_size, (size_t)mk::WS_END); grid = -1; return; }
        int dev = 0, cus = 0, per_cu = 0;
        hipGetDevice(&dev); hipDeviceGetAttribute(&cus, hipDeviceAttributeMultiprocessorCount, dev);
        if (hipFuncSetAttribute((const void*)mk::mk_fwd, hipFuncAttributeMaxDynamicSharedMemorySize, mk::LDS_BYTES) != hipSuccess) { fprintf(stderr, "kernel_launch: hipFuncSetAttribute failed\n"); grid = -1; return; }
        if (hipOccupancyMaxActiveBlocksPerMultiprocessor(&per_cu, (const void*)mk::mk_fwd, 512, mk::LDS_BYTES) != hipSuccess || per_cu < 1) { fprintf(stderr, "kernel_launch: occupancy query says %d\n", per_cu); per_cu = 1; }
        (void)hipGetLastError();
        grid = cus * 1;
        if (grid % 8) grid -= grid % 8;
    }
    if (grid < 0) return;
    if (hipMemsetAsync((char*)d_ws + mk::OFF_BAR, 0, 16384, stream) != hipSuccess) { fprintf(stderr, "kernel_launch: memset of the barrier words failed\n"); return; }
    mk::Args a{};
    for (int i = 0; i < 17; ++i) a.in[i] = (const float*)d_in[i];
    a.out = (float*)d_out; a.ws = (unsigned char*)d_ws;
#if MK_N_LAUNCHES == 1
    a.ph_lo = 0; a.ph_hi = 10;
    void* args[] = {(void*)&a};
    hipError_t e = hipLaunchCooperativeKernel((const void*)mk::mk_fwd, dim3(grid), dim3(512), args, mk::LDS_BYTES, stream);
    if (e != hipSuccess) fprintf(stderr, "kernel_launch: cooperative launch failed: %s (grid %d)\n", hipGetErrorString(e), grid);
#else
    for (int p = 0; p < 10; ++p) { a.ph_lo = p; a.ph_hi = p + 1; hipLaunchKernelGGL(mk::mk_fwd, dim3(grid), dim3(512), mk::LDS_BYTES, stream, a); }
#endif
}
```

```cpp
#include <hip/hip_runtime.h>
#include <hip/hip_cooperative_groups.h>
#include <cstdio>
#include <cstdint>
namespace cg = cooperative_groups;
namespace pg8 {
#define PG8_LAS __attribute__((address_space(3)))
typedef unsigned short bf16_t;
typedef short bf16x8 __attribute__((ext_vector_type(8)));
typedef float f32x4 __attribute__((ext_vector_type(4)));
typedef unsigned u32x4 __attribute__((ext_vector_type(4)));
constexpr int BM = 256, BK = 64, HALF = 128, HTB = HALF * BK * 2  , STAGE_BYTES = 8 * HTB, NXCD = 8, WGM = 8;

__host__ __device__ __forceinline__ int lds_byte(int r, int c) { const int st = (r >> 4) * 2 + (c >> 5), rr = r & 15, cc = c & 31, ob = rr * 64 + cc * 2; return st * 1024 + (ob ^ (((ob >> 9) & 1) << 5)); }
__host__ __device__ __forceinline__ void stage_rc(int b, int& R, int& C) { const int st = b / 1024, sb = b % 1024, swz = sb ^ (((sb >> 9) & 1) << 5); R = (st >> 1) * 16 + swz / 64; C = (st & 1) * 32 + (swz % 64) / 2; }
__host__ __device__ __forceinline__ int perm32(int rho) { const int n = rho >> 4, i = rho & 15; return 8 * (i >> 2) + 4 * n + (i & 3); }

struct Unit { int pm, pn; };
struct Gemm { const bf16_t* A; const bf16_t* Bt; int M, N, K; int a_blocked; };

struct StaticOrder {
    int nM, nN, nwg, G, c;
    __host__ __device__ void init(int M, int N, int G_, int c_) { nM = M / BM; nN = N / BM; nwg = nM * nN; G = G_; c = c_; }
    __host__ __device__ bool next(int i, Unit& u) const {
        const long L = (long)i * G + c; if (L >= nwg) return false;
        int wgid = (int)L; { const int q = nwg / NXCD, r = nwg % NXCD, xcd = wgid % NXCD, off = wgid / NXCD; wgid = (xcd < r ? xcd * (q + 1) : r * (q + 1) + (xcd - r) * q) + off; }
        const int nig = WGM * nN, gid = wgid / nig, fm = gid * WGM, gsz = (nM - fm) < WGM ? (nM - fm) : WGM;
        u.pm = fm + ((wgid % nig) % gsz); u.pn = (wgid % nig) / gsz; return true;
    }
    __device__ __forceinline__ void a_ready(const Unit&) const {}
    __device__ __forceinline__ void done(const Unit&) const {}
};
__device__ __forceinline__ unsigned cvt_pk_bf16(float lo, float hi) { unsigned r; asm volatile("v_cvt_pk_bf16_f32 %0, %1, %2" : "=v"(r) : "v"(lo), "v"(hi)); return r; }

__device__ __forceinline__ size_t blk1024(int row, int col) { return (((size_t)(row >> 8) * 16 + (col >> 6)) * 256 + (row & 255)) * 64 + (col & 63); }
__device__ __forceinline__ float silu_f(float x) { return x * __builtin_amdgcn_rcpf(1.0f + __builtin_amdgcn_exp2f(-1.4426950408889634f * x)); }
__device__ __forceinline__ float rstd_of(float ss) { return __builtin_amdgcn_rsqf(ss * (1.0f / 1024.0f) + 1e-6f); }

struct EpiGateUp {
    static constexpr bool PERM = true, AFTER_DRAIN = false;
    bf16_t* H; const float* ss; int enabled;
    __device__ __forceinline__ void operator()(const f32x4 (&acc)[2][2][4][2], const Unit& u, int wr, int wc, int fr, int fq) const {
        if (!enabled) return;
        const int row0 = u.pm * BM + wr * 64 + fr, hcol = u.pn * 128 + wc * 32 + fq * 8;
        float ssv[2][4];
#pragma unroll
        for (int ai = 0; ai < 2; ++ai)
#pragma unroll
            for (int m = 0; m < 4; ++m) ssv[ai][m] = ss[row0 + ai * HALF + m * 16];
#pragma unroll
        for (int ai = 0; ai < 2; ++ai)
#pragma unroll
            for (int m = 0; m < 4; ++m) {
                const int row = row0 + ai * HALF + m * 16; const float rs = rstd_of(ssv[ai][m]);
                const f32x4 g0 = acc[ai][0][m][0] * rs, g1 = acc[ai][1][m][0] * rs, u0 = acc[ai][0][m][1] * rs, u1 = acc[ai][1][m][1] * rs;
                u32x4 w;
                w.x = cvt_pk_bf16(silu_f(g0[0]) * u0[0], silu_f(g0[1]) * u0[1]); w.y = cvt_pk_bf16(silu_f(g0[2]) * u0[2], silu_f(g0[3]) * u0[3]);
                w.z = cvt_pk_bf16(silu_f(g1[0]) * u1[0], silu_f(g1[1]) * u1[1]); w.w = cvt_pk_bf16(silu_f(g1[2]) * u1[2], silu_f(g1[3]) * u1[3]);
                *(u32x4*)(H + (((size_t)u.pm * 44 + (hcol >> 6)) * 256 + (row & 255)) * 64 + (hcol & 63)) = w;
                asm volatile("" ::: "memory");
            }
    }
};

struct EpiResid {
    static constexpr bool PERM = true, AFTER_DRAIN = false;
    const float* res_lo; const float* res_hi; int split;
    float* out; bf16_t* xb; float* ssout; float alpha; int res_bf16, write_xb;
    __device__ __forceinline__ void operator()(const f32x4 (&acc)[2][2][4][2], const Unit& u, int wr, int wc, int fr, int fq) const {
        const int row0 = u.pm * BM + wr * 64 + fr, col0 = u.pn * BM + wc * 32 + fq * 8;
        const float* rbase = (u.pm * BM < split) ? res_lo : res_hi - (size_t)split * 1024;
        auto row_out = [&](const int ai, const int m, const f32x4 (&r0)[2], const f32x4 (&r1)[2]) {
            const int row = row0 + ai * HALF + m * 16; float s = 0.f;
#pragma unroll
            for (int bj = 0; bj < 2; ++bj) {
                const size_t off = (size_t)row * 1024 + col0 + bj * HALF;
                const f32x4 v0 = r0[bj] + alpha * acc[ai][bj][m][0], v1 = r1[bj] + alpha * acc[ai][bj][m][1];
                if (out) { *(f32x4*)(out + off) = v0; *(f32x4*)(out + off + 4) = v1; }
                if (write_xb) { u32x4 w; w.x = cvt_pk_bf16(v0[0], v0[1]); w.y = cvt_pk_bf16(v0[2], v0[3]); w.z = cvt_pk_bf16(v1[0], v1[1]); w.w = cvt_pk_bf16(v1[2], v1[3]); *(u32x4*)(xb + blk1024(row, col0 + bj * HALF)) = w; }
                s += (v0[0] * v0[0] + v0[1] * v0[1]) + (v0[2] * v0[2] + v0[3] * v0[3]) + (v1[0] * v1[0] + v1[1] * v1[1]) + (v1[2] * v1[2] + v1[3] * v1[3]);
            }
            s += __shfl_xor(s, 16); s += __shfl_xor(s, 32);
            if (fq == 0) atomicAdd(ssout + row, s);
        };
        if (res_bf16) {
            u32x4 rb[2][4][2];
#pragma unroll
            for (int ai = 0; ai < 2; ++ai)
#pragma unroll
                for (int m = 0; m < 4; ++m)
#pragma unroll
                    for (int bj = 0; bj < 2; ++bj) rb[ai][m][bj] = *(const u32x4*)(xb + blk1024(row0 + ai * HALF + m * 16, col0 + bj * HALF));
#pragma unroll
            for (int ai = 0; ai < 2; ++ai) {
#pragma unroll
                for (int m = 0; m < 4; ++m) { f32x4 r0[2], r1[2];
#pragma unroll
                    for (int bj = 0; bj < 2; ++bj) { const u32x4 w = rb[ai][m][bj];
                        r0[bj] = (f32x4){__uint_as_float(w.x << 16), __uint_as_float(w.x & 0xffff0000u), __uint_as_float(w.y << 16), __uint_as_float(w.y & 0xffff0000u)};
                        r1[bj] = (f32x4){__uint_as_float(w.z << 16), __uint_as_float(w.z & 0xffff0000u), __uint_as_float(w.w << 16), __uint_as_float(w.w & 0xffff0000u)}; }
                    row_out(ai, m, r0, r1); }
                asm volatile("" ::: "memory");
            }
        } else {
#pragma unroll
            for (int ai = 0; ai < 2; ++ai) {
                f32x4 rr[4][2][2];
#pragma unroll
                for (int m = 0; m < 4; ++m)
#pragma unroll
                    for (int bj = 0; bj < 2; ++bj) { const size_t off = (size_t)(row0 + ai * HALF + m * 16) * 1024 + col0 + bj * HALF;
                        rr[m][bj][0] = *(const f32x4*)(rbase + off); rr[m][bj][1] = *(const f32x4*)(rbase + off + 4); }
#pragma unroll
                for (int m = 0; m < 4; ++m) { const f32x4 r0[2] = {rr[m][0][0], rr[m][1][0]}, r1[2] = {rr[m][0][1], rr[m][1][1]}; row_out(ai, m, r0, r1); }
                asm volatile("" ::: "memory");
            }
        }
    }
};

struct EpiQkv {
    static constexpr bool PERM = true, AFTER_DRAIN = false;
    bf16_t* P; const float* ss; const float* rope;
    __device__ __forceinline__ void operator()(const f32x4 (&acc)[2][2][4][2], const Unit& u, int wr, int wc, int fr, int fq) const {
        const int row0 = u.pm * BM + wr * 64 + fr, col0 = u.pn * BM + wc * 32 + fq * 8; const int pn = u.pn;
        const bool isq = (pn <= 1) || (pn == 3) || (pn == 4);
        const float qs = isq ? 0.125f * 1.4426950408889634f : 1.0f;
        float ssv[2][4];
#pragma unroll
        for (int ai = 0; ai < 2; ++ai)
#pragma unroll
            for (int m = 0; m < 4; ++m) ssv[ai][m] = ss[row0 + ai * HALF + m * 16];
        const bool rot0 = (pn <= 6) && ((wc & 1) == 0), rot1 = rot0 && (pn != 2);
        const bool act = fq < 2;
        f32x4 cs[2][4][2];
        if (rot0) {
#pragma unroll
            for (int ai = 0; ai < 2; ++ai)
#pragma unroll
                for (int m = 0; m < 4; ++m) { const float* rp = rope + (size_t)((row0 + ai * HALF + m * 16) & 4095) * 16 + 4 * (fq & 1);
                    cs[ai][m][0] = *(const f32x4*)(rp); cs[ai][m][1] = *(const f32x4*)(rp + 8); }
        }
#pragma unroll
        for (int ai = 0; ai < 2; ++ai) {
#pragma unroll
            for (int m = 0; m < 4; ++m) {
                const int row = row0 + ai * HALF + m * 16; const float rs = rstd_of(ssv[ai][m]) * qs;
#pragma unroll
                for (int bj = 0; bj < 2; ++bj) {
                    f32x4 v0 = acc[ai][bj][m][0] * rs, v1 = acc[ai][bj][m][1] * rs;
                    if ((bj == 0 ? rot0 : rot1) && act) { const f32x4 c = cs[ai][m][0], sn = cs[ai][m][1]; const f32x4 t0 = v0 * c - v1 * sn, t1 = v1 * c + v0 * sn; v0 = t0; v1 = t1; }
                    u32x4 w; w.x = cvt_pk_bf16(v0[0], v0[1]); w.y = cvt_pk_bf16(v0[2], v0[3]); w.z = cvt_pk_bf16(v1[0], v1[1]); w.w = cvt_pk_bf16(v1[2], v1[3]);
                    *(u32x4*)(P + (size_t)row * 2304 + col0 + bj * HALF) = w;
                }
            }
            asm volatile("" ::: "memory");
        }
    }
};
template <class Epi, class Sched, bool ALIGN_EPI = false, bool SP2 = false>
__device__ __forceinline__ void gemm_phase(PG8_LAS unsigned char* lds, const Gemm g, const Sched& S, const Epi& E, const int tid) {
    const int  wid = __builtin_amdgcn_readfirstlane(tid >> 6), lane = tid & 63, wr = wid >> 2, wc = wid & 3, fr = lane & 15, fq = lane >> 4;
    const int K = g.K, nt = K / BK;
    unsigned voffA[2], voffB[2];
#pragma unroll
    for (int i = 0; i < 2; ++i) { int R, C; stage_rc(tid * 16 + i * 8192, R, C); const int Rb = Epi::PERM ? ((R & ~31) + perm32(R & 31)) : R;
        voffA[i] = (unsigned)(R * (g.a_blocked ? BK : K) + C) * 2u; voffB[i] = (unsigned)(Rb * BK + C) * 2u; }
    const bool ablk = g.a_blocked != 0;
    const size_t kstepB = (size_t)BM * BK * 2, hstepB = (size_t)HALF * BK * 2, tstepB = (size_t)nt * BM * BK * 2;
    const size_t kstepA = ablk ? kstepB : (size_t)(BK * 2), hstepA = ablk ? hstepB : (size_t)HALF * K * 2, tstepA = ablk ? tstepB : (size_t)BM * K * 2;
    const unsigned ldsw = (unsigned)wid * 1024u;
    const int aoff = lds_byte(wr * 64 + fr, fq * 8), boff = lds_byte(wc * 32 + fr, fq * 8);
#define PG8_SA(b, h) (((b) * 2 + (h)) * HTB)
#define PG8_SB(b, h) ((4 + (b) * 2 + (h)) * HTB)
#define PG8_STAGE(bufoff, gbase, voff) do { _Pragma("unroll") for (int _i = 0; _i < 2; ++_i) \
        __builtin_amdgcn_global_load_lds((const unsigned*)((const char*)(gbase) + (voff)[_i]), (PG8_LAS unsigned*)(lds + (bufoff) + ldsw + _i * 8192), 16, 0, 0); } while (0)
#define PG8_LDA(dst, b, h) do { _Pragma("unroll") for (int m = 0; m < 4; ++m) _Pragma("unroll") for (int k = 0; k < 2; ++k) dst[m][k] = *(const PG8_LAS bf16x8*)(lds + PG8_SA(b, h) + aoff + m * 2048 + k * 1024); } while (0)
#define PG8_LDB(dst, b, h) do { _Pragma("unroll") for (int n = 0; n < 2; ++n) _Pragma("unroll") for (int k = 0; k < 2; ++k) dst[n][k] = *(const PG8_LAS bf16x8*)(lds + PG8_SB(b, h) + boff + n * 2048 + k * 1024); } while (0)
#define PG8_MMA(ai, bj, At, Bt) do { __builtin_amdgcn_s_setprio(1); _Pragma("unroll") for (int m = 0; m < 4; ++m) _Pragma("unroll") for (int n = 0; n < 2; ++n) _Pragma("unroll") for (int k = 0; k < 2; ++k) \
        acc[ai][bj][m][n] = __builtin_amdgcn_mfma_f32_16x16x32_bf16(Bt[n][k], At[m][k], acc[ai][bj][m][n], 0, 0, 0); __builtin_amdgcn_s_setprio(0); } while (0)
#define PG8_WAIT_V(n) asm volatile("s_waitcnt vmcnt(" #n ")" ::: "memory")
#define PG8_WAIT_L(n) asm volatile("s_waitcnt lgkmcnt(" #n ")" ::: "memory")
#define PG8_BAR __builtin_amdgcn_s_barrier()
#define PG8_SCHED __builtin_amdgcn_sched_barrier(0)
    Unit cur, nxt; int ui = 0;
    if (!S.next(0, cur)) return;
    f32x4 acc[2][2][4][2];
#pragma unroll
    for (int a = 0; a < 2; ++a)
#pragma unroll
        for (int b = 0; b < 2; ++b)
#pragma unroll
            for (int m = 0; m < 4; ++m)
#pragma unroll
                for (int n = 0; n < 2; ++n) acc[a][b][m][n] = (f32x4){0.f, 0.f, 0.f, 0.f};
    bf16x8 At[4][2], B0[2][2], B1[2][2];
    const char* cA = (const char*)g.A + (size_t)cur.pm * tstepA; const char* cB = (const char*)g.Bt + (size_t)cur.pn * tstepB;
    S.a_ready(cur);
    if constexpr (SP2) {
        PG8_STAGE(PG8_SB(0, 0), cB, voffB); PG8_STAGE(PG8_SB(0, 1), cB + hstepB, voffB); PG8_STAGE(PG8_SA(0, 0), cA, voffA); PG8_STAGE(PG8_SA(0, 1), cA + hstepA, voffA);
        if (wr == 1) PG8_BAR;
        PG8_WAIT_V(2); PG8_BAR;
        PG8_STAGE(PG8_SB(1, 0), cB + kstepB, voffB); PG8_STAGE(PG8_SA(1, 0), cA + kstepA, voffA); PG8_STAGE(PG8_SB(1, 1), cB + hstepB + kstepB, voffB);
        PG8_WAIT_V(6); PG8_BAR;
    } else {
        PG8_STAGE(PG8_SB(0, 0), cB, voffB); PG8_STAGE(PG8_SA(0, 0), cA, voffA); PG8_STAGE(PG8_SB(0, 1), cB + hstepB, voffB); PG8_STAGE(PG8_SA(0, 1), cA + hstepA, voffA);
        if (wr == 1) PG8_BAR;
        PG8_WAIT_V(4); PG8_BAR;
        PG8_STAGE(PG8_SB(1, 0), cB + kstepB, voffB); PG8_STAGE(PG8_SA(1, 0), cA + kstepA, voffA); PG8_STAGE(PG8_SB(1, 1), cB + hstepB + kstepB, voffB);
        PG8_WAIT_V(6); PG8_BAR;
    }
    for (;;) {
        const bool has_next = S.next(ui + 1, nxt);
        const char* nA = has_next ? (const char*)g.A + (size_t)nxt.pm * tstepA : cA; const char* nB = has_next ? (const char*)g.Bt + (size_t)nxt.pn * tstepB : cB;
        for (int t = 0; t < nt; t += 2) {
            const bool last = (t == nt - 2);
            const char* a1 = cA + (size_t)(t + 1) * kstepA;
            const char* a2 = last ? nA : cA + (size_t)(t + 2) * kstepA; const char* b2 = last ? nB : cB + (size_t)(t + 2) * kstepB;
            const char* a3 = a2 + kstepA; const char* b3 = b2 + kstepB;
            if (last && has_next) S.a_ready(nxt);
            if constexpr (SP2) {
            PG8_LDB(B0, 0, 0); PG8_LDB(B1, 0, 1); PG8_SCHED; PG8_LDA(At, 0, 0); PG8_STAGE(PG8_SA(1, 1), a1 + hstepA, voffA);
            PG8_WAIT_V(8); PG8_WAIT_L(0); PG8_BAR; PG8_MMA(0, 0, At, B0); PG8_MMA(0, 1, At, B1); PG8_BAR; PG8_SCHED;
            PG8_LDA(At, 0, 1); PG8_STAGE(PG8_SB(0, 0), b2, voffB); PG8_STAGE(PG8_SB(0, 1), b2 + hstepB, voffB); PG8_STAGE(PG8_SA(0, 0), a2, voffA);
            PG8_WAIT_V(8); PG8_WAIT_L(0); PG8_BAR; PG8_MMA(1, 0, At, B0); PG8_MMA(1, 1, At, B1); PG8_BAR; PG8_SCHED;
            PG8_LDB(B0, 1, 0); PG8_LDB(B1, 1, 1); PG8_SCHED; PG8_LDA(At, 1, 0); PG8_STAGE(PG8_SA(0, 1), a2 + hstepA, voffA);
            PG8_WAIT_V(8); PG8_WAIT_L(0); PG8_BAR; PG8_MMA(0, 0, At, B0); PG8_MMA(0, 1, At, B1); PG8_BAR; PG8_SCHED;
            PG8_LDA(At, 1, 1); PG8_STAGE(PG8_SB(1, 0), b3, voffB); PG8_STAGE(PG8_SB(1, 1), b3 + hstepB, voffB); PG8_STAGE(PG8_SA(1, 0), a3, voffA);
            PG8_WAIT_V(8); PG8_WAIT_L(0); PG8_BAR; PG8_MMA(1, 0, At, B0); PG8_MMA(1, 1, At, B1); PG8_BAR; PG8_SCHED;
            } else {
            PG8_LDB(B0, 0, 0); PG8_SCHED; PG8_LDA(At, 0, 0); PG8_STAGE(PG8_SA(1, 1), a1 + hstepA, voffA);
            PG8_WAIT_L(8); PG8_BAR; PG8_WAIT_L(0); PG8_MMA(0, 0, At, B0); PG8_BAR; PG8_SCHED;
            PG8_LDB(B1, 0, 1); PG8_STAGE(PG8_SB(0, 0), b2, voffB);
            PG8_BAR; PG8_WAIT_L(0); PG8_MMA(0, 1, At, B1); PG8_BAR;
            PG8_LDA(At, 0, 1); PG8_STAGE(PG8_SA(0, 0), a2, voffA);
            PG8_BAR; PG8_WAIT_L(0); PG8_MMA(1, 0, At, B0); PG8_BAR; PG8_SCHED;
            PG8_STAGE(PG8_SB(0, 1), b2 + hstepB, voffB);
            PG8_WAIT_V(6); PG8_BAR; PG8_MMA(1, 1, At, B1); PG8_BAR;
            PG8_LDB(B0, 1, 0); PG8_SCHED; PG8_LDA(At, 1, 0); PG8_STAGE(PG8_SA(0, 1), a2 + hstepA, voffA);
            PG8_WAIT_L(8); PG8_BAR; PG8_WAIT_L(0); PG8_MMA(0, 0, At, B0); PG8_BAR; PG8_SCHED;
            PG8_LDB(B1, 1, 1); PG8_STAGE(PG8_SB(1, 0), b3, voffB);
            PG8_BAR; PG8_WAIT_L(0); PG8_MMA(0, 1, At, B1); PG8_BAR;
            PG8_LDA(At, 1, 1); PG8_STAGE(PG8_SA(1, 0), a3, voffA);
            PG8_BAR; PG8_WAIT_L(0); PG8_MMA(1, 0, At, B0); PG8_BAR; PG8_SCHED;
            PG8_STAGE(PG8_SB(1, 1), b3 + hstepB, voffB);
            PG8_WAIT_V(6); PG8_BAR; PG8_MMA(1, 1, At, B1); PG8_BAR;
            }
        }
        if constexpr (ALIGN_EPI) { if (wr == 0) PG8_BAR; }
        if constexpr (!Epi::AFTER_DRAIN) { E(acc, cur, wr, wc, fr, fq); S.done(cur); }
        if (!has_next) break;
#pragma unroll
        for (int a = 0; a < 2; ++a)
#pragma unroll
            for (int b = 0; b < 2; ++b)
#pragma unroll
                for (int m = 0; m < 4; ++m)
#pragma unroll
                    for (int n = 0; n < 2; ++n) acc[a][b][m][n] = (f32x4){0.f, 0.f, 0.f, 0.f};
        cur = nxt; cA = nA; cB = nB; ++ui;
        if constexpr (ALIGN_EPI) { if (wr == 1) PG8_BAR; }
    }
    PG8_WAIT_V(0);
    if constexpr (!ALIGN_EPI) { if (wr == 0) PG8_BAR; }
    PG8_BAR;
    if constexpr (Epi::AFTER_DRAIN) { E.fused(acc, cur, wr, wc, fr, fq, lds, wid, lane); S.done(cur); }
#undef PG8_SA
#undef PG8_SB
#undef PG8_STAGE
#undef PG8_LDA
#undef PG8_LDB
#undef PG8_MMA
#undef PG8_WAIT_V
#undef PG8_WAIT_L
#undef PG8_BAR
#undef PG8_SCHED
}
}

namespace mk {
using pg8::bf16_t;
typedef short bf16x8 __attribute__((ext_vector_type(8)));
typedef short s16x4 __attribute__((ext_vector_type(4)));
typedef float f32x16 __attribute__((ext_vector_type(16)));
typedef float f32x4 __attribute__((ext_vector_type(4)));
typedef unsigned u32x4 __attribute__((ext_vector_type(4)));
#define MK_LAS __attribute__((address_space(3)))
constexpr int T = 98304, TP = 65536, D = 1024, FF = 2816, INW = 2304, SEQ = 4096;
constexpr int LDS_BYTES = 133120;
constexpr float INV0 = 1.000000000e+00f, INV1 = 1.939227447e-01f, INV2 = 3.760603093e-02f, INV3 = 7.292664737e-03f, INV4 = 1.414213562e-03f, INV5 = 2.742481757e-04f, INV6 = 5.318295897e-05f, INV7 = 1.031338538e-05f;
constexpr size_t OFF_BIG = 0;
constexpr size_t OFF_MERGED = (size_t)T * FF * 2;
constexpr size_t OFF_XB = OFF_MERGED + (size_t)T * D * 2;
constexpr size_t OFF_LSE = OFF_XB + (size_t)T * D * 2;
constexpr size_t OFF_W = OFF_LSE + (size_t)3 * T * 8 * 4;
constexpr size_t SZ_GU = (size_t)2 * FF * D * 2, SZ_DN = (size_t)D * FF * 2, SZ_IN = (size_t)INW * D * 2, SZ_OUT = (size_t)D * D * 2;
constexpr size_t OFF_GU1 = OFF_W, OFF_DN1 = OFF_GU1 + SZ_GU, OFF_GU2 = OFF_DN1 + SZ_DN, OFF_DN2 = OFF_GU2 + SZ_GU, OFF_WIN = OFF_DN2 + SZ_DN, OFF_WOUT = OFF_WIN + SZ_IN;
constexpr size_t OFF_SS = OFF_WOUT + SZ_OUT;
constexpr size_t OFF_ROPE = OFF_SS + (size_t)5 * T * 4;
constexpr size_t OFF_BAR = OFF_ROPE + (size_t)SEQ * 16 * 4;
constexpr size_t WS_END = OFF_BAR + 16384;

struct Args { const float* in[17]; float* out; unsigned char* ws; int ph_lo, ph_hi; };

__device__ __forceinline__ unsigned pk2(float lo, float hi) { return pg8::cvt_pk_bf16(lo, hi); }
__device__ __forceinline__ float wave_sum(float v) {
#pragma unroll
    for (int o = 1; o < 64; o <<= 1) v += __shfl_xor(v, o);
    return v;
}
#define MK_LDS_WAIT() asm volatile("s_waitcnt lgkmcnt(0)" ::: "memory")

__device__ __forceinline__ void p0_weight_item(const float* W0, const float* W1, int kind, int K, int Nsrc, const float* gain0, const float* gain1, bf16_t* WT, MK_LAS float* scr, int item, int nblk, int lane) {
    const int kb = item / nblk, nb = item % nblk, k0 = 64 * kb, n0 = 32 * nb;
    const int ng = lane & 7, kg = lane >> 3, R = n0 + 4 * ng;
    const float* src; int col;
    if (kind == 0) { const int n = (R >> 2) & 1; col = 128 * (R >> 8) + 32 * ((R >> 5) & 3) + 8 * ((R >> 3) & 3) + 4 * ((R >> 7) & 1); src = n ? W1 : W0; }
    else if (kind == 2) { const int hd = R >> 6, lc = R & 63; const bool qk = (hd < 10) || (hd >= 12 && hd < 28);
        col = (qk && lc < 16) ? (R & ~15) + ((lc >> 2) & 1) * 8 + ((lc >> 3) & 1) * 4 : R; src = W0; }
    else { col = R; src = W0; }
    f32x4 wv[8]; float gv[8];
#pragma unroll
    for (int i = 0; i < 8; ++i) { const int k = k0 + 8 * i + kg;
        wv[i] = *(const f32x4*)(src + (size_t)k * Nsrc + col);
        gv[i] = gain0 ? ((gain1 && k >= 512) ? gain1[k - 512] : gain0[k]) : 1.0f; }
#pragma unroll
    for (int i = 0; i < 8; ++i) { MK_LAS float* d = scr + (8 * i + kg) * 33 + 4 * ng;
        d[0] = wv[i][0] * gv[i]; d[1] = wv[i][1] * gv[i]; d[2] = wv[i][2] * gv[i]; d[3] = wv[i][3] * gv[i]; }
    MK_LDS_WAIT();
    const int c = lane & 7;
#pragma unroll
    for (int j = 0; j < 4; ++j) { const int n = (lane >> 3) + 8 * j; const MK_LAS float* s = scr + (8 * c) * 33 + n;
        u32x4 o; o.x = pk2(s[0 * 33], s[1 * 33]); o.y = pk2(s[2 * 33], s[3 * 33]); o.z = pk2(s[4 * 33], s[5 * 33]); o.w = pk2(s[6 * 33], s[7 * 33]);
        *(u32x4*)(WT + ((((size_t)((n0 + n) >> 8)) * (K >> 6) + (k0 >> 6)) * 256 + ((n0 + n) & 255)) * 64 + 8 * c) = o; }
    MK_LDS_WAIT();
}

__device__ __forceinline__ void phase_prologue(const Args& a, MK_LAS unsigned char* lds, int gw, int NGW, int wave, int lane) {
    MK_LAS float* scr = (MK_LAS float*)(lds + wave * 8448);
    unsigned char* ws = a.ws;
    constexpr int I_GU = (D / 64) * (2 * FF / 32), I_DN = (FF / 64) * (D / 32), I_IN = (D / 64) * (INW / 32), I_OUT = (D / 64) * (D / 32);
    constexpr int NITEMS = 2 * I_GU + 2 * I_DN + I_IN + I_OUT;
    for (int it = gw; it < NITEMS; it += NGW) {
        int r = it; const float *W0, *W1 = nullptr, *g0 = nullptr, *g1 = nullptr; int kind = 1, K = D, Nsrc = D; size_t woff;
        if (r < 2 * I_GU) { const bool s2 = r >= I_GU; r -= s2 ? I_GU : 0; W0 = a.in[s2 ? 13 : 3]; W1 = a.in[s2 ? 14 : 4]; g0 = a.in[s2 ? 12 : 2]; kind = 0; Nsrc = FF; woff = s2 ? OFF_GU2 : OFF_GU1; }
        else if (r < 2 * I_GU + 2 * I_DN) { r -= 2 * I_GU; const bool s2 = r >= I_DN; r -= s2 ? I_DN : 0; W0 = a.in[s2 ? 15 : 5]; K = FF; woff = s2 ? OFF_DN2 : OFF_DN1; }
        else if (r < 2 * I_GU + 2 * I_DN + I_IN) { r -= 2 * I_GU + 2 * I_DN; W0 = a.in[7]; g0 = a.in[6]; Nsrc = INW; kind = 2; woff = OFF_WIN; }
        else { r -= 2 * I_GU + 2 * I_DN + I_IN; W0 = a.in[11]; g0 = a.in[9]; g1 = a.in[10]; woff = OFF_WOUT; }
        const int nblk = (kind == 0 ? 2 * FF : Nsrc) / 32;
        p0_weight_item(W0, W1, kind, K, Nsrc, g0, g1, (bf16_t*)(ws + woff), scr, r, nblk, lane);
    }
    bf16_t* xb = (bf16_t*)(ws + OFF_XB); float* ss = (float*)(ws + OFF_SS);
    constexpr int RB = 4;
    for (int row0 = gw * RB; row0 < T; row0 += NGW * RB) {
        f32x4 v[RB][4];
#pragma unroll
        for (int q = 0; q < RB; ++q) { const int row = row0 + q; const float* xr = row < TP ? a.in[0] + (size_t)row * D : a.in[1] + (size_t)(row - TP) * D;
#pragma unroll
            for (int j = 0; j < 2; ++j) { v[q][2 * j] = *(const f32x4*)(xr + j * 512 + lane * 8); v[q][2 * j + 1] = *(const f32x4*)(xr + j * 512 + lane * 8 + 4); } }
#pragma unroll
        for (int q = 0; q < RB; ++q) { const int row = row0 + q; float s = 0.f;
#pragma unroll
            for (int j = 0; j < 2; ++j) { const f32x4 v0 = v[q][2 * j], v1 = v[q][2 * j + 1];
                s += (v0[0] * v0[0] + v0[1] * v0[1]) + (v0[2] * v0[2] + v0[3] * v0[3]) + (v1[0] * v1[0] + v1[1] * v1[1]) + (v1[2] * v1[2] + v1[3] * v1[3]);
                u32x4 w; w.x = pk2(v0[0], v0[1]); w.y = pk2(v0[2], v0[3]); w.z = pk2(v1[0], v1[1]); w.w = pk2(v1[2], v1[3]);
                *(u32x4*)(xb + pg8::blk1024(row, j * 512 + lane * 8)) = w; }
            s = wave_sum(s);
            if (lane == 0) { ss[row] = s; ss[T + row] = 0.f; ss[2 * T + row] = 0.f; ss[3 * T + row] = 0.f; } }
    }
    float* rope = (float*)(ws + OFF_ROPE);
    for (int i = gw * 64 + lane; i < SEQ * 8; i += NGW * 64) {
        const int pos = i >> 3, j = i & 7;
        const float inv = j == 0 ? INV0 : j == 1 ? INV1 : j == 2 ? INV2 : j == 3 ? INV3 : j == 4 ? INV4 : j == 5 ? INV5 : j == 6 ? INV6 : INV7;
        const float ang = (float)pos * inv;
        double tr = (double)ang * 0.15915494309189535; tr -= __builtin_floor(tr);
        const float fr = (float)tr;
        rope[pos * 16 + j] = __builtin_amdgcn_cosf(fr); rope[pos * 16 + 8 + j] = __builtin_amdgcn_sinf(fr);
    }
}

__device__ __forceinline__ int crow(int r, int hi) { return (r & 3) + 8 * (r >> 2) + 4 * hi; }
typedef short v4i16_t __attribute__((ext_vector_type(4)));
__device__ __forceinline__ s16x4 vtr(const MK_LAS unsigned char* p) { return __builtin_bit_cast(s16x4, __builtin_amdgcn_ds_read_tr16_b64_v4i16((MK_LAS v4i16_t*)p)); }
#define MK_MFMA32(a, b, c) __builtin_amdgcn_mfma_f32_32x32x16_bf16(a, b, c, 0, 0, 0)
constexpr int ATT_NK = 384, ATT_KCS = (ATT_NK + 2) * 16  , ATT_VOFF = 49408, ATT_VDS = ATT_NK * 64 + 128  , ATT_WOFF = ATT_VOFF + 2 * ATT_VDS, ATT_WSZ = 4224;
static_assert(8 * ATT_KCS <= ATT_VOFF && ATT_WOFF + 8 * ATT_WSZ <= LDS_BYTES, "attention LDS map");
constexpr float ATT_THR = 8.0f;
#define MK_WAIT_BAR() asm volatile("s_waitcnt lgkmcnt(0)\n\ts_barrier" ::: "memory")

struct AttItem {
    size_t rowbase;
    int qcol, kcol, vcol;
    int stride, res, hw, L;
    int kb0, NK;
    int q0;
    int isA;
    bf16_t* out; int out_ld, out_col;
    float* lse;
};
__device__ __forceinline__ void att_decode(const Args& a, int id, AttItem& I) {
    unsigned char* ws = a.ws;
    bf16_t* merged = (bf16_t*)(ws + OFF_MERGED);
    constexpr int NA = 24 * 2 * 64;
    if (id < NA) {
        const int n = id >> 7, kvh = (id >> 6) & 1, qb = id & 63;
        I.rowbase = (size_t)n * SEQ; I.qcol = kvh * 256; I.kcol = 512 + kvh * 64; I.vcol = 640 + kvh * 64;
        I.stride = 1; I.res = 0; I.hw = 128; I.L = SEQ; I.kb0 = 64 * qb - 128; I.NK = 320; I.q0 = 64 * qb; I.isA = 1;
        I.out = merged; I.out_ld = 1024; I.out_col = kvh * 256; I.lse = nullptr;
    } else {
        const int idb = id - NA; const int n = idb / 384, rem = idb - n * 384, h = rem / 48, k = rem - h * 48, g = k >> 4, f = k & 15;
        const int sh = 2 * g, dd = 1 << sh, c = f >> sh;
        I.rowbase = (size_t)n * SEQ; I.qcol = 768 + h * 64; I.kcol = 1280 + h * 64; I.vcol = 1792 + h * 64;
        I.stride = dd; I.res = f & (dd - 1); I.hw = 64; I.L = SEQ >> sh; I.kb0 = 256 * c - 64; I.NK = 384; I.q0 = 256 * c; I.isA = 0;
        if (g == 0) { I.out = merged; I.out_ld = 1024; I.out_col = 512 + h * 64; }
        else { I.out = (bf16_t*)a.out + (size_t)(g - 1) * T * 512; I.out_ld = 512; I.out_col = h * 64; }
        I.lse = (float*)(ws + OFF_LSE) + (size_t)g * T * 8 + h;
    }
}
__device__ __forceinline__ void att_prefetch(const bf16_t* __restrict__ proj, const AttItem& I, int tid, int wave, u32x4 (&kr)[6], u32x4 (&vr)[6], bf16x8 (&qr)[4]) {
    const size_t tokstride = (size_t)I.stride * INW;
    {
        const int lane = tid & 63, r32 = lane & 31, hi = lane >> 5;
        const int hsel = I.isA ? (wave & 3) : 0, t0 = I.q0 + 32 * (I.isA ? (wave >> 2) : wave);
        const bf16_t* qp = proj + (I.rowbase + I.res) * INW + (size_t)(t0 + r32) * tokstride + I.qcol + hsel * 64 + hi * 8;
#pragma unroll
        for (int d0 = 0; d0 < 4; ++d0) qr[d0] = *(const bf16x8*)(qp + d0 * 16);
    }
    const bf16_t* seq0 = proj + (I.rowbase + I.res) * INW + (tid & 7) * 8;
#pragma unroll
    for (int i = 0; i < 6; ++i) {
        const int row = i * 64 + (tid >> 3), key = I.kb0 + row;
        if (row < I.NK && key >= 0 && key < I.L) { const bf16_t* p = seq0 + (size_t)key * tokstride; kr[i] = *(const u32x4*)(p + I.kcol); vr[i] = *(const u32x4*)(p + I.vcol); }
        else { kr[i] = (u32x4){0u, 0u, 0u, 0u}; vr[i] = (u32x4){0u, 0u, 0u, 0u}; }
    }
}
__device__ __forceinline__ void att_store(MK_LAS unsigned char* lds, int tid, const u32x4 (&kr)[6], const u32x4 (&vr)[6]) {
    const int chunk = tid & 7;
    MK_LAS unsigned char* kp = lds + chunk * ATT_KCS + (tid >> 3) * 16;
    MK_LAS unsigned char* vp = lds + ATT_VOFF + (chunk >> 2) * ATT_VDS + (tid >> 3) * 64 + (chunk & 3) * 16;
#pragma unroll
    for (int i = 0; i < 6; ++i) { *(MK_LAS u32x4*)(kp + i * 64 * 16) = kr[i]; *(MK_LAS u32x4*)(vp + i * 64 * 64) = vr[i]; }
}

struct AttPend { bf16_t* p; size_t step; float* lsep; float lsev; int valid; };
__device__ __forceinline__ void att_flush(const AttPend& P, MK_LAS unsigned char* lds, int wave, int lane) {
    if (!P.valid) return;
    const MK_LAS bf16_t* stg = (const MK_LAS bf16_t*)(lds + ATT_WOFF + wave * ATT_WSZ);
#pragma unroll
    for (int i = 0; i < 4; ++i) { const int row = i * 8 + (lane >> 3), ch = lane & 7; *(u32x4*)(P.p + i * P.step) = *(const MK_LAS u32x4*)(stg + row * 64 + ch * 8); }
    if (P.lsep) *P.lsep = P.lsev;
}
__device__ __forceinline__ void att_compute(const AttItem& I, MK_LAS unsigned char* lds, int wave, int lane, const bf16x8 (&qr)[4], const float sink_l2, const bool do_store, AttPend& P) {
    const int r32 = lane & 31, hi = lane >> 5;
    MK_LAS unsigned char* wl = lds + ATT_WOFF + wave * ATT_WSZ;
    MK_LAS float* wsf = (MK_LAS float*)(wl + 4096);
    const int hsel = I.isA ? (wave & 3) : 0;
    const int t0 = I.q0 + 32 * (I.isA ? (wave >> 2) : wave);
    const int ocol = I.out_col + hsel * 64;
    const int nkt = I.hw / 16 + 1;
    const int kt_lo = t0 >= I.hw ? 0 : ((I.hw - t0) >> 5);
    int kt_hi = (I.L - t0 + I.hw) >> 5; kt_hi = kt_hi < nkt ? kt_hi : nkt;
    const MK_LAS unsigned char* kfb = lds + hi * ATT_KCS + r32 * 16;
    const MK_LAS unsigned char* vfb = lds + ATT_VOFF + ((lane >> 4) & 1) * 32 + (lane & 3) * 8 + (4 * hi + ((lane & 15) >> 2)) * 64;
    float mhat = -1.0e4f, lsum = 0.f;
    f32x16 o0 = {}, o1 = {};
    for (int kt = kt_lo; kt < kt_hi; ++kt) {
        const int krow0 = t0 - I.hw + 32 * kt - I.kb0;
        const MK_LAS unsigned char* kp = kfb + krow0 * 16;
        bf16x8 kf[4];
#pragma unroll
        for (int d0 = 0; d0 < 4; ++d0) kf[d0] = *(const MK_LAS bf16x8*)(kp + 2 * d0 * ATT_KCS);
        const MK_LAS unsigned char* vp = vfb + krow0 * 64;
#define MK_VFR(off) __builtin_shufflevector(vtr(vp + (off)), vtr(vp + (off) + 512), 0, 1, 2, 3, 4, 5, 6, 7)
        const bf16x8 v00 = MK_VFR(0), v01 = MK_VFR(ATT_VDS), v10 = MK_VFR(1024), v11 = MK_VFR(ATT_VDS + 1024);
#undef MK_VFR
        f32x16 p = {};
#pragma unroll
        for (int d0 = 0; d0 < 4; ++d0) p = MK_MFMA32(kf[d0], qr[d0], p);
        if (kt == 0) {
#pragma unroll
            for (int r = 0; r < 16; ++r) if (crow(r, hi) < r32) p[r] = -1.0e30f;
        }
        if (kt == nkt - 1) {
#pragma unroll
            for (int r = 0; r < 16; ++r) if (crow(r, hi) > r32) p[r] = -1.0e30f;
        }
        float rm = __builtin_fmaxf(p[0], p[1]);
#pragma unroll
        for (int r = 2; r < 16; ++r) rm = __builtin_fmaxf(rm, p[r]);
        rm = __builtin_fmaxf(rm, __shfl_xor(rm, 32));
        if (__any(rm > mhat + ATT_THR)) {
            const float mnew = __builtin_fmaxf(mhat, rm), f = __builtin_amdgcn_exp2f(mhat - mnew);
            lsum *= f; mhat = mnew;
            if (hi == 0) wsf[r32] = f;
            MK_LDS_WAIT();
#pragma unroll
            for (int g = 0; g < 4; ++g) { const f32x4 w4 = *(const MK_LAS f32x4*)(wsf + 8 * g + 4 * hi);
#pragma unroll
                for (int j = 0; j < 4; ++j) { o0[4 * g + j] *= w4[j]; o1[4 * g + j] *= w4[j]; } }
            MK_LDS_WAIT();
        }
        float sacc = 0.f;
#pragma unroll
        for (int r = 0; r < 16; ++r) { p[r] = __builtin_amdgcn_exp2f(p[r] - mhat); sacc += p[r]; }
        lsum += sacc;
        u32x4 pw0, pw1;
        pw0.x = pk2(p[0], p[1]); pw0.y = pk2(p[2], p[3]); pw0.z = pk2(p[4], p[5]); pw0.w = pk2(p[6], p[7]);
        pw1.x = pk2(p[8], p[9]); pw1.y = pk2(p[10], p[11]); pw1.z = pk2(p[12], p[13]); pw1.w = pk2(p[14], p[15]);
        o0 = MK_MFMA32(__builtin_bit_cast(bf16x8, pw0), v00, o0); o1 = MK_MFMA32(__builtin_bit_cast(bf16x8, pw0), v01, o1);
        o0 = MK_MFMA32(__builtin_bit_cast(bf16x8, pw1), v10, o0); o1 = MK_MFMA32(__builtin_bit_cast(bf16x8, pw1), v11, o1);
    }
    float ltot = lsum + __shfl_xor(lsum, 32);
    if (I.isA) ltot += __builtin_amdgcn_exp2f(sink_l2 - mhat);
    const float rl = 1.0f / ltot;
    if (hi == 0) wsf[r32] = rl;
    MK_LDS_WAIT();
    MK_LAS bf16_t* stg = (MK_LAS bf16_t*)wl;
#pragma unroll
    for (int g = 0; g < 4; ++g) { const f32x4 w4 = *(const MK_LAS f32x4*)(wsf + 8 * g + 4 * hi);
#pragma unroll
        for (int j = 0; j < 4; ++j) { const int r = 4 * g + j, orow = crow(r, hi);
            stg[orow * 64 + r32] = (bf16_t)(pk2(o0[r] * w4[j], 0.f) & 0xffffu); stg[orow * 64 + 32 + r32] = (bf16_t)(pk2(o1[r] * w4[j], 0.f) & 0xffffu); } }
    MK_LDS_WAIT();
    P.valid = do_store ? 1 : 0;
    P.p = I.out + (I.rowbase + I.res + (size_t)I.stride * (t0 + (lane >> 3))) * I.out_ld + ocol + (lane & 7) * 8;
    P.step = (size_t)8 * I.stride * I.out_ld;
    P.lsep = (I.lse && hi == 0) ? I.lse + (I.rowbase + I.res + (size_t)I.stride * (t0 + r32)) * 8 : nullptr;
    P.lsev = mhat + __builtin_log2f(ltot);
}

__device__ __forceinline__ void phase_attention(const Args& a, MK_LAS unsigned char* lds, int vcu, int G, int tid, int wave, int lane, const int mode) {
    const bf16_t* proj = (const bf16_t*)(a.ws + OFF_BIG);
    constexpr int NITEMS = 24 * 2 * 64 + 24 * 8 * 48;
    u32x4 kr[6], vr[6]; bf16x8 qn[4];
    int id = vcu;
    AttItem I;
#pragma unroll
    for (int i = 0; i < 6; ++i) { kr[i] = (u32x4){0u, 0u, 0u, 0u}; vr[i] = kr[i]; }
#pragma unroll
    for (int i = 0; i < 4; ++i) qn[i] = (bf16x8){0, 0, 0, 0, 0, 0, 0, 0};
    AttPend P; P.valid = 0; P.p = nullptr; P.step = 0; P.lsep = nullptr; P.lsev = 0.f;
    const float sinkA = a.in[8][wave & 3] * 1.4426950408889634f, sinkB = a.in[8][4 + (wave & 3)] * 1.4426950408889634f;
    if (id < NITEMS) { att_decode(a, id, I); if (mode != 1) att_prefetch(proj, I, tid, wave, kr, vr, qn); }
    while (id < NITEMS) {
        if (mode != 1) att_store(lds, tid, kr, vr);
        att_flush(P, lds, wave, lane);
        bf16x8 qr[4];
#pragma unroll
        for (int d0 = 0; d0 < 4; ++d0) qr[d0] = qn[d0];
        MK_WAIT_BAR();
        const int nid = id + G;
        if (nid < NITEMS && mode != 1) { AttItem N; att_decode(a, nid, N); att_prefetch(proj, N, tid, wave, kr, vr, qn); }
        if (mode != 2) att_compute(I, lds, wave, lane, qr, (I.qcol >> 8) ? sinkB : sinkA, mode == 0, P);
        MK_WAIT_BAR();
        id = nid;
        if (id < NITEMS) att_decode(a, id, I);
    }
    att_flush(P, lds, wave, lane);
}

__device__ __forceinline__ void unpack8(const u32x4 w, float (&v)[8]) {
    v[0] = __uint_as_float(w.x << 16); v[1] = __uint_as_float(w.x & 0xffff0000u); v[2] = __uint_as_float(w.y << 16); v[3] = __uint_as_float(w.y & 0xffff0000u);
    v[4] = __uint_as_float(w.z << 16); v[5] = __uint_as_float(w.z & 0xffff0000u); v[6] = __uint_as_float(w.w << 16); v[7] = __uint_as_float(w.w & 0xffff0000u);
}
__device__ __forceinline__ u32x4 pack8(const float (&v)[8], float s) { u32x4 w; w.x = pk2(v[0] * s, v[1] * s); w.y = pk2(v[2] * s, v[3] * s); w.z = pk2(v[4] * s, v[5] * s); w.w = pk2(v[6] * s, v[7] * s); return w; }
__device__ __forceinline__ void phase_finalize(const Args& a, int gw, int NGW, int lane) {
    unsigned char* ws = a.ws;
    bf16_t* merged = (bf16_t*)(ws + OFF_MERGED); const bf16_t* ob2 = (const bf16_t*)a.out; const bf16_t* ob3 = ob2 + (size_t)T * 512; const float* lse = (const float*)(ws + OFF_LSE);
    const int h = lane >> 3;
    constexpr int RB = 4;
    for (int row0 = gw * RB; row0 < T; row0 += NGW * RB) {
        u32x4 wa[RB], w1[RB], w2[RB], w3[RB]; float l1[RB], l2[RB], l3[RB];
#pragma unroll
        for (int q = 0; q < RB; ++q) { const size_t row = row0 + q; const bf16_t* mr = merged + row * 1024;
            wa[q] = *(const u32x4*)(mr + lane * 8); w1[q] = *(const u32x4*)(mr + 512 + lane * 8);
            w2[q] = *(const u32x4*)(ob2 + row * 512 + lane * 8); w3[q] = *(const u32x4*)(ob3 + row * 512 + lane * 8);
            l1[q] = lse[row * 8 + h]; l2[q] = lse[(size_t)T * 8 + row * 8 + h]; l3[q] = lse[(size_t)2 * T * 8 + row * 8 + h]; }
#pragma unroll
        for (int q = 0; q < RB; ++q) { bf16_t* mr = merged + (size_t)(row0 + q) * 1024;
            float va[8], b1[8], b2[8], b3[8];
            unpack8(wa[q], va); unpack8(w1[q], b1); unpack8(w2[q], b2); unpack8(w3[q], b3);
            const float mx = __builtin_fmaxf(l1[q], __builtin_fmaxf(l2[q], l3[q]));
            const float e1 = __builtin_amdgcn_exp2f(l1[q] - mx), e2 = __builtin_amdgcn_exp2f(l2[q] - mx), e3 = __builtin_amdgcn_exp2f(l3[q] - mx), ri = 1.0f / (e1 + e2 + e3);
            const float c1 = e1 * ri, c2 = e2 * ri, c3 = e3 * ri;
            float sa = 0.f, sb = 0.f;
#pragma unroll
            for (int j = 0; j < 8; ++j) { b1[j] = c1 * b1[j] + c2 * b2[j] + c3 * b3[j]; sa += va[j] * va[j]; sb += b1[j] * b1[j]; }
            sa = wave_sum(sa); sb = wave_sum(sb);
            const float ra = __builtin_amdgcn_rsqf(sa * (1.0f / 512.0f) + 1e-6f), rb = __builtin_amdgcn_rsqf(sb * (1.0f / 512.0f) + 1e-6f);
            *(u32x4*)(mr + lane * 8) = pack8(va, ra);
            *(u32x4*)(mr + 512 + lane * 8) = pack8(b1, rb); }
    }
}

__device__ __forceinline__ void phase_final_norm(const Args& a, int gw, int NGW, int lane) {
    const float* ss = (const float*)(a.ws + OFF_SS) + (size_t)3 * T; const float* gain = a.in[16]; const bf16_t* xb = (const bf16_t*)(a.ws + OFF_XB);
    f32x4 g[4];
#pragma unroll
    for (int j = 0; j < 2; ++j) { g[2 * j] = *(const f32x4*)(gain + j * 512 + lane * 8); g[2 * j + 1] = *(const f32x4*)(gain + j * 512 + lane * 8 + 4); }
    constexpr int RB = 8;
    for (int row0 = gw * RB; row0 < T; row0 += NGW * RB) {
        u32x4 v[RB][2]; float rs[RB];
#pragma unroll
        for (int q = 0; q < RB; ++q) { rs[q] = ss[row0 + q];
#pragma unroll
            for (int j = 0; j < 2; ++j) v[q][j] = *(const u32x4*)(xb + pg8::blk1024(row0 + q, j * 512 + lane * 8)); }
#pragma unroll
        for (int q = 0; q < RB; ++q) { float* xr = a.out + (size_t)(row0 + q) * D; const float r = pg8::rstd_of(rs[q]);
#pragma unroll
            for (int j = 0; j < 2; ++j) { float f[8]; unpack8(v[q][j], f);
                const f32x4 o0 = (f32x4){f[0], f[1], f[2], f[3]} * r * g[2 * j], o1 = (f32x4){f[4], f[5], f[6], f[7]} * r * g[2 * j + 1];
                *(f32x4*)(xr + j * 512 + lane * 8) = o0; *(f32x4*)(xr + j * 512 + lane * 8 + 4) = o1; } }
    }
}


#define XB_TMO      128
#define XB_XCNT(j)  (256  + 64 * (j))
#define XB_XSUB(j)  (1280 + 64 * (j))
#define XB_XGEN(j)  (2304 + 64 * (j))
#define XB_TOP      3328
#define XB_TOPGEN   3392
#define XCD_BAR_WORDS 3456
#define XB_SPIN_CAP (1u << 18)
__device__ __forceinline__ unsigned xb_ld(unsigned* p)              { return __hip_atomic_load(p, __ATOMIC_RELAXED, __HIP_MEMORY_SCOPE_AGENT); }
__device__ __forceinline__ unsigned xb_add(unsigned* p, unsigned v) { return __hip_atomic_fetch_add(p, v, __ATOMIC_RELAXED, __HIP_MEMORY_SCOPE_AGENT); }
__device__ __forceinline__ unsigned xb_xcc_id() { return (unsigned)__builtin_amdgcn_s_getreg((3 << 11) | 20) & 0xFu; }
#define XB_SPIN(cond, bar) do { unsigned _sp = 0; while (cond) { __builtin_amdgcn_s_sleep(1); \
    if ((++_sp & 255u) == 0u) { if (xb_ld(&(bar)[XB_TMO])) break; if (_sp > XB_SPIN_CAP) { atomicAdd(&(bar)[XB_TMO], 1u); break; } } } } while (0)
struct XcdBarrier { unsigned* bar; unsigned x; volatile MK_LAS unsigned* st; };
__device__ __forceinline__ void xcd_barrier_complete(unsigned* bar, unsigned x, unsigned& nloc, unsigned& nx) {
    const unsigned G = gridDim.x * gridDim.y * gridDim.z;
    unsigned sum, cnt, mine, sp = 0u;
    for (;;) {
        sum = 0u; cnt = 0u; mine = 0u;
#pragma unroll
        for (unsigned j = 0; j < 16; ++j) { const unsigned c = xb_ld(&bar[XB_XCNT(j)]); sum += c; cnt += (c > 0u) ? 1u : 0u; mine = (j == x) ? c : mine; }
        if (sum == G) break;
        __builtin_amdgcn_s_sleep(1);
        if ((++sp & 255u) == 0u) { if (xb_ld(&bar[XB_TMO])) break; if (sp > XB_SPIN_CAP) { atomicAdd(&bar[XB_TMO], 1u); break; } }
    }
    nloc = mine > 0u ? mine : 1u; nx = cnt > 0u ? cnt : 1u;
}
__device__ __forceinline__ void xcd_barrier(const XcdBarrier& b) {
    asm volatile("s_waitcnt vmcnt(0)" ::: "memory");
    __syncthreads();
    if (threadIdx.x == 0) {
        unsigned* bar = b.bar;
        __builtin_amdgcn_s_waitcnt(0);
        unsigned nloc = b.st[0], nx = b.st[1];
        if (nloc == 0u) { xcd_barrier_complete(bar, b.x, nloc, nx); b.st[0] = nloc; b.st[1] = nx; }
        const unsigned old = xb_add(&bar[XB_XSUB(b.x)], 1u);
        const unsigned gen = old / nloc;
        if (old + 1u == (gen + 1u) * nloc) {
            __builtin_amdgcn_fence(__ATOMIC_RELEASE, "agent");
            asm volatile("s_waitcnt vmcnt(0)" ::: "memory");
            const unsigned og = xb_add(&bar[XB_TOP], 1u);
            const unsigned tg = og / nx;
            if (og + 1u == (tg + 1u) * nx) xb_add(&bar[XB_TOPGEN], 1u);
            else XB_SPIN(xb_ld(&bar[XB_TOPGEN]) == tg, bar);
            __builtin_amdgcn_fence(__ATOMIC_ACQUIRE, "agent");
            xb_add(&bar[XB_XGEN(b.x)], 1u);
            asm volatile("s_waitcnt vmcnt(0)" ::: "memory");
        } else {
            XB_SPIN(xb_ld(&bar[XB_XGEN(b.x)]) == gen, bar);
            __builtin_amdgcn_fence(__ATOMIC_ACQUIRE, "agent");
            asm volatile("s_waitcnt vmcnt(0)" ::: "memory");
        }
    }
    __syncthreads();
}

constexpr int NPHASE = 10;
#ifndef MK_STAG_GU
#define MK_STAG_GU 0
#endif
__device__ __forceinline__ void mk_stagger(int bid, int ticks) {
    const int g = (bid >> 3) & 7;
    if (ticks > 0 && g) { const unsigned long long t0 = __builtin_amdgcn_s_memrealtime(), w = (unsigned long long)(g * ticks);
        while (__builtin_amdgcn_s_memrealtime() - t0 < w) __builtin_amdgcn_s_sleep(4); }
}
#ifndef MK_MASK
#define MK_MASK 0x3ff
#endif
#define MK_ON(p) ((MK_MASK >> (p)) & 1)
__global__ __launch_bounds__(512) void mk_fwd(const Args a) {
    extern __shared__ __attribute__((aligned(16))) unsigned char lds_raw[];
    MK_LAS unsigned char* lds = (MK_LAS unsigned char*)lds_raw;
    cg::grid_group grid = cg::this_grid();
    volatile MK_LAS unsigned* xst = (volatile MK_LAS unsigned*)(lds + LDS_BYTES - 16);
    if (threadIdx.x == 0) { xst[0] = 0u; xst[1] = 0u; (void)xb_add(&((unsigned*)(a.ws + OFF_BAR))[XB_XCNT(xb_xcc_id())], 1u); }
    __syncthreads();
#ifndef MK_REP
#define MK_REP 0
#endif
#ifndef MK_GU_PROBE
#define MK_GU_PROBE 1
#endif
#ifndef MK_ATT_PROBE
#define MK_ATT_PROBE 0
#endif
    for (int ph2 = a.ph_lo * 2; ph2 < a.ph_hi * 2; ++ph2) {
        const int ph = ph2 >> 1;
        if ((ph2 & 1) && !((MK_REP >> ph) & 1)) continue;
        if (ph2 > a.ph_lo * 2) {
            if (a.ph_hi > NPHASE) grid.sync();
            else { XcdBarrier xb; xb.bar = (unsigned*)(a.ws + OFF_BAR); xb.x = xb_xcc_id(); xb.st = xst; xcd_barrier(xb); }
        }
        int tid = threadIdx.x; asm volatile("" : "+v"(tid));
        const int lane = tid & 63, wave = __builtin_amdgcn_readfirstlane(tid >> 6);
        int G = gridDim.x, bid = blockIdx.x; asm volatile("" : "+s"(G), "+s"(bid));
        const int vcu = (bid & 7) * (G >> 3) + (bid >> 3);
        const int gw = vcu * 8 + wave, NGW = G * 8;
        size_t wzero = 0; asm volatile("" : "+s"(wzero)); unsigned char* ws = a.ws + wzero;
        float* ss = (float*)(ws + OFF_SS);
        if (MK_ON(0) && ph == 0) phase_prologue(a, lds, gw, NGW, wave, lane);
        else if (MK_ON(1) && (ph == 1 || ph == 7)) {
            const bool second = ph == 7;
            mk_stagger(bid, MK_STAG_GU);
            pg8::Gemm g; g.A = (const bf16_t*)(ws + OFF_XB); g.Bt = (const bf16_t*)(ws + (second ? OFF_GU2 : OFF_GU1)); g.M = T; g.N = 2 * FF; g.K = D; g.a_blocked = 1;
            pg8::StaticOrder S; S.init(T, 2 * FF, G, bid);
            pg8::EpiGateUp E; E.H = (bf16_t*)(ws + OFF_BIG); E.ss = ss + (second ? 2 * (size_t)T : 0); E.enabled = (ph2 & 1) ? MK_GU_PROBE : 1;
            pg8::gemm_phase<pg8::EpiGateUp, pg8::StaticOrder, true, true>(lds, g, S, E, tid);
        } else if (MK_ON(2) && (ph == 2 || ph == 6 || ph == 8)) {
            pg8::Gemm g; pg8::EpiResid E; E.split = TP; E.res_lo = a.in[0]; E.res_hi = a.in[1]; E.xb = (bf16_t*)(ws + OFF_XB);
            if (ph == 2) { g.A = (const bf16_t*)(ws + OFF_BIG); g.Bt = (const bf16_t*)(ws + OFF_DN1); g.K = FF; E.out = nullptr; E.res_bf16 = 0; E.write_xb = 1; E.ssout = ss + T; E.alpha = 0.5f; }
            else if (ph == 6) { g.A = (const bf16_t*)(ws + OFF_MERGED); g.Bt = (const bf16_t*)(ws + OFF_WOUT); g.K = D; E.out = nullptr; E.res_bf16 = 1; E.write_xb = 1; E.ssout = ss + 2 * (size_t)T; E.alpha = 1.0f; }
            else { g.A = (const bf16_t*)(ws + OFF_BIG); g.Bt = (const bf16_t*)(ws + OFF_DN2); g.K = FF; E.out = nullptr; E.res_bf16 = 1; E.write_xb = 1; E.ssout = ss + 3 * (size_t)T; E.alpha = 0.5f; }
            g.M = T; g.N = D; g.a_blocked = (ph == 6) ? 0 : 1;
            pg8::StaticOrder S; S.init(T, D, G, bid);
            pg8::gemm_phase<pg8::EpiResid, pg8::StaticOrder, true, true>(lds, g, S, E, tid);
        } else if (MK_ON(3) && ph == 3) {
            pg8::Gemm g; g.A = (const bf16_t*)(ws + OFF_XB); g.Bt = (const bf16_t*)(ws + OFF_WIN); g.M = T; g.N = INW; g.K = D; g.a_blocked = 1;
            pg8::StaticOrder S; S.init(T, INW, G, bid);
            pg8::EpiQkv E; E.P = (bf16_t*)(ws + OFF_BIG); E.ss = ss + T; E.rope = (const float*)(ws + OFF_ROPE);
            pg8::gemm_phase<pg8::EpiQkv, pg8::StaticOrder, true, true>(lds, g, S, E, tid);
        } else if (MK_ON(4) && ph == 4) phase_attention(a, lds, vcu, G, tid, wave, lane, (ph2 & 1) ? MK_ATT_PROBE : 0);
        else if (MK_ON(5) && ph == 5) phase_finalize(a, gw, NGW, lane);
        else if (MK_ON(9) && ph == 9) phase_final_norm(a, gw, NGW, lane);
    }
}
}

#ifndef MK_N_LAUNCHES
#define MK_N_LAUNCHES 1
#endif
extern "C" void kernel_launch(void* const* d_in, const int* in_sizes, int n_in, void* d_out, int out_size, void* d_ws, size_t ws_size, hipStream_t stream) {
    static int grid = 0;
    if (grid == 0) {
        if (n_in != 17 || out_size != mk::T * mk::D || ws_size < mk::WS_END) { fprintf(stderr, "kernel_launch: unexpected shapes (n_in %d out %d ws %zu need %zu)\n", n_in, out_size, ws_size, (size_t)mk::WS_END); grid = -1; return; }
        int dev = 0, cus = 0, per_cu = 0;
        hipGetDevice(&dev); hipDeviceGetAttribute(&cus, hipDeviceAttributeMultiprocessorCount, dev);
        if (hipFuncSetAttribute((const void*)mk::mk_fwd, hipFuncAttributeMaxDynamicSharedMemorySize, mk::LDS_BYTES) != hipSuccess) { fprintf(stderr, "kernel_launch: hipFuncSetAttribute failed\n"); grid = -1; return; }
        if (hipOccupancyMaxActiveBlocksPerMultiprocessor(&per_cu, (const void*)mk::mk_fwd, 512, mk::LDS_BYTES) != hipSuccess || per_cu < 1) { fprintf(stderr, "kernel_launch: occupancy query says %d\n", per_cu); per_cu = 1; }
        (void)hipGetLastError();
        grid = cus * 1;
        if (grid % 8) grid -= grid % 8;
    }
    if (grid < 0) return;
    if (hipMemsetAsync((char*)d_ws + mk::OFF_BAR, 0, 16384, stream) != hipSuccess) { fprintf(stderr, "kernel_launch: memset of the barrier words failed\n"); return; }
    mk::Args a{};
    for (int i = 0; i < 17; ++i) a.in[i] = (const float*)d_in[i];
    a.out = (float*)d_out; a.ws = (unsigned char*)d_ws;
#if MK_N_LAUNCHES == 1
    a.ph_lo = 0; a.ph_hi = 10;
    void* args[] = {(void*)&a};
    hipError_t e = hipLaunchCooperativeKernel((const void*)mk::mk_fwd, dim3(grid), dim3(512), args, mk::LDS_BYTES, stream);
    if (e != hipSuccess) fprintf(stderr, "kernel_launch: cooperative launch failed: %s (grid %d)\n", hipGetErrorString(e), grid);
#else
    for (int p = 0; p < 10; ++p) { a.ph_lo = p; a.ph_hi = p + 1; hipLaunchKernelGGL(mk::mk_fwd, dim3(grid), dim3(512), mk::LDS_BYTES, stream, a); }
#endif
}
```

```cpp
#include <hip/hip_runtime.h>
#include <hip/hip_cooperative_groups.h>
#include <cstdio>
#include <cstdint>
namespace cg = cooperative_groups;
namespace pg8 {
#define PG8_LAS __attribute__((address_space(3)))
typedef unsigned short bf16_t;
typedef short bf16x8 __attribute__((ext_vector_type(8)));
typedef float f32x4 __attribute__((ext_vector_type(4)));
typedef unsigned u32x4 __attribute__((ext_vector_type(4)));
constexpr int BM = 256, BK = 64, HALF = 128, HTB = HALF * BK * 2  , STAGE_BYTES = 8 * HTB, NXCD = 8, WGM = 8;

__host__ __device__ __forceinline__ int lds_byte(int r, int c) { const int st = (r >> 4) * 2 + (c >> 5), rr = r & 15, cc = c & 31, ob = rr * 64 + cc * 2; return st * 1024 + (ob ^ (((ob >> 9) & 1) << 5)); }
__host__ __device__ __forceinline__ void stage_rc(int b, int& R, int& C) { const int st = b / 1024, sb = b % 1024, swz = sb ^ (((sb >> 9) & 1) << 5); R = (st >> 1) * 16 + swz / 64; C = (st & 1) * 32 + (swz % 64) / 2; }
__host__ __device__ __forceinline__ int perm32(int rho) { const int n = rho >> 4, i = rho & 15; return 8 * (i >> 2) + 4 * n + (i & 3); }

struct Unit { int pm, pn; };
struct Gemm { const bf16_t* A; const bf16_t* Bt; int M, N, K; int a_blocked; };

struct StaticOrder {
    int nM, nN, nwg, G, c;
    __host__ __device__ void init(int M, int N, int G_, int c_) { nM = M / BM; nN = N / BM; nwg = nM * nN; G = G_; c = c_; }
    __host__ __device__ bool next(int i, Unit& u) const {
        const long L = (long)i * G + c; if (L >= nwg) return false;
        int wgid = (int)L; { const int q = nwg / NXCD, r = nwg % NXCD, xcd = wgid % NXCD, off = wgid / NXCD; wgid = (xcd < r ? xcd * (q + 1) : r * (q + 1) + (xcd - r) * q) + off; }
        const int nig = WGM * nN, gid = wgid / nig, fm = gid * WGM, gsz = (nM - fm) < WGM ? (nM - fm) : WGM;
        u.pm = fm + ((wgid % nig) % gsz); u.pn = (wgid % nig) / gsz; return true;
    }
    __device__ __forceinline__ void a_ready(const Unit&) const {}
    __device__ __forceinline__ void done(const Unit&) const {}
};
__device__ __forceinline__ unsigned cvt_pk_bf16(float lo, float hi) { unsigned r; asm volatile("v_cvt_pk_bf16_f32 %0, %1, %2" : "=v"(r) : "v"(lo), "v"(hi)); return r; }

__device__ __forceinline__ size_t blk1024(int row, int col) { return (((size_t)(row >> 8) * 16 + (col >> 6)) * 256 + (row & 255)) * 64 + (col & 63); }
__device__ __forceinline__ float silu_f(float x) { return x * __builtin_amdgcn_rcpf(1.0f + __builtin_amdgcn_exp2f(-1.4426950408889634f * x)); }
__device__ __forceinline__ float rstd_of(float ss) { return __builtin_amdgcn_rsqf(ss * (1.0f / 1024.0f) + 1e-6f); }

struct EpiGateUp {
    static constexpr bool PERM = true, AFTER_DRAIN = false;
    bf16_t* H; const float* ss; int enabled;
    __device__ __forceinline__ void operator()(const f32x4 (&acc)[2][2][4][2], const Unit& u, int wr, int wc, int fr, int fq) const {
        if (!enabled) return;
        const int row0 = u.pm * BM + wr * 64 + fr, hcol = u.pn * 128 + wc * 32 + fq * 8;
        float ssv[2][4];
#pragma unroll
        for (int ai = 0; ai < 2; ++ai)
#pragma unroll
            for (int m = 0; m < 4; ++m) ssv[ai][m] = ss[row0 + ai * HALF + m * 16];
#pragma unroll
        for (int ai = 0; ai < 2; ++ai)
#pragma unroll
            for (int m = 0; m < 4; ++m) {
                const int row = row0 + ai * HALF + m * 16; const float rs = rstd_of(ssv[ai][m]);
                const f32x4 g0 = acc[ai][0][m][0] * rs, g1 = acc[ai][1][m][0] * rs, u0 = acc[ai][0][m][1] * rs, u1 = acc[ai][1][m][1] * rs;
                u32x4 w;
                w.x = cvt_pk_bf16(silu_f(g0[0]) * u0[0], silu_f(g0[1]) * u0[1]); w.y = cvt_pk_bf16(silu_f(g0[2]) * u0[2], silu_f(g0[3]) * u0[3]);
                w.z = cvt_pk_bf16(silu_f(g1[0]) * u1[0], silu_f(g1[1]) * u1[1]); w.w = cvt_pk_bf16(silu_f(g1[2]) * u1[2], silu_f(g1[3]) * u1[3]);
                *(u32x4*)(H + (((size_t)u.pm * 44 + (hcol >> 6)) * 256 + (row & 255)) * 64 + (hcol & 63)) = w;
                asm volatile("" ::: "memory");
            }
    }
};

struct EpiResid {
    static constexpr bool PERM = true, AFTER_DRAIN = false;
    const float* res_lo; const float* res_hi; int split;
    float* out; bf16_t* xb; float* ssout; float alpha; int res_bf16, write_xb;
    __device__ __forceinline__ void operator()(const f32x4 (&acc)[2][2][4][2], const Unit& u, int wr, int wc, int fr, int fq) const {
        const int row0 = u.pm * BM + wr * 64 + fr, col0 = u.pn * BM + wc * 32 + fq * 8;
        const float* rbase = (u.pm * BM < split) ? res_lo : res_hi - (size_t)split * 1024;
        auto row_out = [&](const int ai, const int m, const f32x4 (&r0)[2], const f32x4 (&r1)[2]) {
            const int row = row0 + ai * HALF + m * 16; float s = 0.f;
#pragma unroll
            for (int bj = 0; bj < 2; ++bj) {
                const size_t off = (size_t)row * 1024 + col0 + bj * HALF;
                const f32x4 v0 = r0[bj] + alpha * acc[ai][bj][m][0], v1 = r1[bj] + alpha * acc[ai][bj][m][1];
                if (out) { *(f32x4*)(out + off) = v0; *(f32x4*)(out + off + 4) = v1; }
                if (write_xb) { u32x4 w; w.x = cvt_pk_bf16(v0[0], v0[1]); w.y = cvt_pk_bf16(v0[2], v0[3]); w.z = cvt_pk_bf16(v1[0], v1[1]); w.w = cvt_pk_bf16(v1[2], v1[3]); *(u32x4*)(xb + blk1024(row, col0 + bj * HALF)) = w; }
                s += (v0[0] * v0[0] + v0[1] * v0[1]) + (v0[2] * v0[2] + v0[3] * v0[3]) + (v1[0] * v1[0] + v1[1] * v1[1]) + (v1[2] * v1[2] + v1[3] * v1[3]);
            }
            s += __shfl_xor(s, 16); s += __shfl_xor(s, 32);
            if (fq == 0) atomicAdd(ssout + row, s);
        };
        if (res_bf16) {
            u32x4 rb[2][4][2];
#pragma unroll
            for (int ai = 0; ai < 2; ++ai)
#pragma unroll
                for (int m = 0; m < 4; ++m)
#pragma unroll
                    for (int bj = 0; bj < 2; ++bj) rb[ai][m][bj] = *(const u32x4*)(xb + blk1024(row0 + ai * HALF + m * 16, col0 + bj * HALF));
#pragma unroll
            for (int ai = 0; ai < 2; ++ai) {
#pragma unroll
                for (int m = 0; m < 4; ++m) { f32x4 r0[2], r1[2];
#pragma unroll
                    for (int bj = 0; bj < 2; ++bj) { const u32x4 w = rb[ai][m][bj];
                        r0[bj] = (f32x4){__uint_as_float(w.x << 16), __uint_as_float(w.x & 0xffff0000u), __uint_as_float(w.y << 16), __uint_as_float(w.y & 0xffff0000u)};
                        r1[bj] = (f32x4){__uint_as_float(w.z << 16), __uint_as_float(w.z & 0xffff0000u), __uint_as_float(w.w << 16), __uint_as_float(w.w & 0xffff0000u)}; }
                    row_out(ai, m, r0, r1); }
                asm volatile("" ::: "memory");
            }
        } else {
#pragma unroll
            for (int ai = 0; ai < 2; ++ai) {
                f32x4 rr[4][2][2];
#pragma unroll
                for (int m = 0; m < 4; ++m)
#pragma unroll
                    for (int bj = 0; bj < 2; ++bj) { const size_t off = (size_t)(row0 + ai * HALF + m * 16) * 1024 + col0 + bj * HALF;
                        rr[m][bj][0] = *(const f32x4*)(rbase + off); rr[m][bj][1] = *(const f32x4*)(rbase + off + 4); }
#pragma unroll
                for (int m = 0; m < 4; ++m) { const f32x4 r0[2] = {rr[m][0][0], rr[m][1][0]}, r1[2] = {rr[m][0][1], rr[m][1][1]}; row_out(ai, m, r0, r1); }
                asm volatile("" ::: "memory");
            }
        }
    }
};

struct EpiQkv {
    static constexpr bool PERM = true, AFTER_DRAIN = false;
    bf16_t* P; const float* ss; const float* rope;
    __device__ __forceinline__ void operator()(const f32x4 (&acc)[2][2][4][2], const Unit& u, int wr, int wc, int fr, int fq) const {
        const int row0 = u.pm * BM + wr * 64 + fr, col0 = u.pn * BM + wc * 32 + fq * 8; const int pn = u.pn;
        const bool isq = (pn <= 1) || (pn == 3) || (pn == 4);
        const float qs = isq ? 0.125f * 1.4426950408889634f : 1.0f;
        float ssv[2][4];
#pragma unroll
        for (int ai = 0; ai < 2; ++ai)
#pragma unroll
            for (int m = 0; m < 4; ++m) ssv[ai][m] = ss[row0 + ai * HALF + m * 16];
        const bool rot0 = (pn <= 6) && ((wc & 1) == 0), rot1 = rot0 && (pn != 2);
        const bool act = fq < 2;
        f32x4 cs[2][4][2];
        if (rot0) {
#pragma unroll
            for (int ai = 0; ai < 2; ++ai)
#pragma unroll
                for (int m = 0; m < 4; ++m) { const float* rp = rope + (size_t)((row0 + ai * HALF + m * 16) & 4095) * 16 + 4 * (fq & 1);
                    cs[ai][m][0] = *(const f32x4*)(rp); cs[ai][m][1] = *(const f32x4*)(rp + 8); }
        }
#pragma unroll
        for (int ai = 0; ai < 2; ++ai) {
#pragma unroll
            for (int m = 0; m < 4; ++m) {
                const int row = row0 + ai * HALF + m * 16; const float rs = rstd_of(ssv[ai][m]) * qs;
#pragma unroll
                for (int bj = 0; bj < 2; ++bj) {
                    f32x4 v0 = acc[ai][bj][m][0] * rs, v1 = acc[ai][bj][m][1] * rs;
                    if ((bj == 0 ? rot0 : rot1) && act) { const f32x4 c = cs[ai][m][0], sn = cs[ai][m][1]; const f32x4 t0 = v0 * c - v1 * sn, t1 = v1 * c + v0 * sn; v0 = t0; v1 = t1; }
                    u32x4 w; w.x = cvt_pk_bf16(v0[0], v0[1]); w.y = cvt_pk_bf16(v0[2], v0[3]); w.z = cvt_pk_bf16(v1[0], v1[1]); w.w = cvt_pk_bf16(v1[2], v1[3]);
                    *(u32x4*)(P + (size_t)row * 2304 + col0 + bj * HALF) = w;
                }
            }
            asm volatile("" ::: "memory");
        }
    }
};
template <class Epi, class Sched, bool ALIGN_EPI = false, bool SP2 = false>
__device__ __forceinline__ void gemm_phase(PG8_LAS unsigned char* lds, const Gemm g, const Sched& S, const Epi& E, const int tid) {
    const int  wid = __builtin_amdgcn_readfirstlane(tid >> 6), lane = tid & 63, wr = wid >> 2, wc = wid & 3, fr = lane & 15, fq = lane >> 4;
    const int K = g.K, nt = K / BK;
    unsigned voffA[2], voffB[2];
#pragma unroll
    for (int i = 0; i < 2; ++i) { int R, C; stage_rc(tid * 16 + i * 8192, R, C); const int Rb = Epi::PERM ? ((R & ~31) + perm32(R & 31)) : R;
        voffA[i] = (unsigned)(R * (g.a_blocked ? BK : K) + C) * 2u; voffB[i] = (unsigned)(Rb * BK + C) * 2u; }
    const bool ablk = g.a_blocked != 0;
    const size_t kstepB = (size_t)BM * BK * 2, hstepB = (size_t)HALF * BK * 2, tstepB = (size_t)nt * BM * BK * 2;
    const size_t kstepA = ablk ? kstepB : (size_t)(BK * 2), hstepA = ablk ? hstepB : (size_t)HALF * K * 2, tstepA = ablk ? tstepB : (size_t)BM * K * 2;
    const unsigned ldsw = (unsigned)wid * 1024u;
    const int aoff = lds_byte(wr * 64 + fr, fq * 8), boff = lds_byte(wc * 32 + fr, fq * 8);
#define PG8_SA(b, h) (((b) * 2 + (h)) * HTB)
#define PG8_SB(b, h) ((4 + (b) * 2 + (h)) * HTB)
#define PG8_STAGE(bufoff, gbase, voff) do { _Pragma("unroll") for (int _i = 0; _i < 2; ++_i) \
        __builtin_amdgcn_global_load_lds((const unsigned*)((const char*)(gbase) + (voff)[_i]), (PG8_LAS unsigned*)(lds + (bufoff) + ldsw + _i * 8192), 16, 0, 0); } while (0)
#define PG8_LDA(dst, b, h) do { _Pragma("unroll") for (int m = 0; m < 4; ++m) _Pragma("unroll") for (int k = 0; k < 2; ++k) dst[m][k] = *(const PG8_LAS bf16x8*)(lds + PG8_SA(b, h) + aoff + m * 2048 + k * 1024); } while (0)
#define PG8_LDB(dst, b, h) do { _Pragma("unroll") for (int n = 0; n < 2; ++n) _Pragma("unroll") for (int k = 0; k < 2; ++k) dst[n][k] = *(const PG8_LAS bf16x8*)(lds + PG8_SB(b, h) + boff + n * 2048 + k * 1024); } while (0)
#define PG8_MMA(ai, bj, At, Bt) do { __builtin_amdgcn_s_setprio(1); _Pragma("unroll") for (int m = 0; m < 4; ++m) _Pragma("unroll") for (int n = 0; n < 2; ++n) _Pragma("unroll") for (int k = 0; k < 2; ++k) \
        acc[ai][bj][m][n] = __builtin_amdgcn_mfma_f32_16x16x32_bf16(Bt[n][k], At[m][k], acc[ai][bj][m][n], 0, 0, 0); __builtin_amdgcn_s_setprio(0); } while (0)
#define PG8_WAIT_V(n) asm volatile("s_waitcnt vmcnt(" #n ")" ::: "memory")
#define PG8_WAIT_L(n) asm volatile("s_waitcnt lgkmcnt(" #n ")" ::: "memory")
#define PG8_BAR __builtin_amdgcn_s_barrier()
#define PG8_SCHED __builtin_amdgcn_sched_barrier(0)
    Unit cur, nxt; int ui = 0;
    if (!S.next(0, cur)) return;
    f32x4 acc[2][2][4][2];
#pragma unroll
    for (int a = 0; a < 2; ++a)
#pragma unroll
        for (int b = 0; b < 2; ++b)
#pragma unroll
            for (int m = 0; m < 4; ++m)
#pragma unroll
                for (int n = 0; n < 2; ++n) acc[a][b][m][n] = (f32x4){0.f, 0.f, 0.f, 0.f};
    bf16x8 At[4][2], B0[2][2], B1[2][2];
    const char* cA = (const char*)g.A + (size_t)cur.pm * tstepA; const char* cB = (const char*)g.Bt + (size_t)cur.pn * tstepB;
    S.a_ready(cur);
    if constexpr (SP2) {
        PG8_STAGE(PG8_SB(0, 0), cB, voffB); PG8_STAGE(PG8_SB(0, 1), cB + hstepB, voffB); PG8_STAGE(PG8_SA(0, 0), cA, voffA); PG8_STAGE(PG8_SA(0, 1), cA + hstepA, voffA);
        if (wr == 1) PG8_BAR;
        PG8_WAIT_V(2); PG8_BAR;
        PG8_STAGE(PG8_SB(1, 0), cB + kstepB, voffB); PG8_STAGE(PG8_SA(1, 0), cA + kstepA, voffA); PG8_STAGE(PG8_SB(1, 1), cB + hstepB + kstepB, voffB);
        PG8_WAIT_V(6); PG8_BAR;
    } else {
        PG8_STAGE(PG8_SB(0, 0), cB, voffB); PG8_STAGE(PG8_SA(0, 0), cA, voffA); PG8_STAGE(PG8_SB(0, 1), cB + hstepB, voffB); PG8_STAGE(PG8_SA(0, 1), cA + hstepA, voffA);
        if (wr == 1) PG8_BAR;
        PG8_WAIT_V(4); PG8_BAR;
        PG8_STAGE(PG8_SB(1, 0), cB + kstepB, voffB); PG8_STAGE(PG8_SA(1, 0), cA + kstepA, voffA); PG8_STAGE(PG8_SB(1, 1), cB + hstepB + kstepB, voffB);
        PG8_WAIT_V(6); PG8_BAR;
    }
    for (;;) {
        const bool has_next = S.next(ui + 1, nxt);
        const char* nA = has_next ? (const char*)g.A + (size_t)nxt.pm * tstepA : cA; const char* nB = has_next ? (const char*)g.Bt + (size_t)nxt.pn * tstepB : cB;
        for (int t = 0; t < nt; t += 2) {
            const bool last = (t == nt - 2);
            const char* a1 = cA + (size_t)(t + 1) * kstepA;
            const char* a2 = last ? nA : cA + (size_t)(t + 2) * kstepA; const char* b2 = last ? nB : cB + (size_t)(t + 2) * kstepB;
            const char* a3 = a2 + kstepA; const char* b3 = b2 + kstepB;
            if (last && has_next) S.a_ready(nxt);
            if constexpr (SP2) {
            PG8_LDB(B0, 0, 0); PG8_LDB(B1, 0, 1); PG8_SCHED; PG8_LDA(At, 0, 0); PG8_STAGE(PG8_SA(1, 1), a1 + hstepA, voffA);
            PG8_WAIT_V(8); PG8_WAIT_L(0); PG8_BAR; PG8_MMA(0, 0, At, B0); PG8_MMA(0, 1, At, B1); PG8_BAR; PG8_SCHED;
            PG8_LDA(At, 0, 1); PG8_STAGE(PG8_SB(0, 0), b2, voffB); PG8_STAGE(PG8_SB(0, 1), b2 + hstepB, voffB); PG8_STAGE(PG8_SA(0, 0), a2, voffA);
            PG8_WAIT_V(8); PG8_WAIT_L(0); PG8_BAR; PG8_MMA(1, 0, At, B0); PG8_MMA(1, 1, At, B1); PG8_BAR; PG8_SCHED;
            PG8_LDB(B0, 1, 0); PG8_LDB(B1, 1, 1); PG8_SCHED; PG8_LDA(At, 1, 0); PG8_STAGE(PG8_SA(0, 1), a2 + hstepA, voffA);
            PG8_WAIT_V(8); PG8_WAIT_L(0); PG8_BAR; PG8_MMA(0, 0, At, B0); PG8_MMA(0, 1, At, B1); PG8_BAR; PG8_SCHED;
            PG8_LDA(At, 1, 1); PG8_STAGE(PG8_SB(1, 0), b3, voffB); PG8_STAGE(PG8_SB(1, 1), b3 + hstepB, voffB); PG8_STAGE(PG8_SA(1, 0), a3, voffA);
            PG8_WAIT_V(8); PG8_WAIT_L(0); PG8_BAR; PG8_MMA(1, 0, At, B0); PG8_MMA(1, 1, At, B1); PG8_BAR; PG8_SCHED;
            } else {
            PG8_LDB(B0, 0, 0); PG8_SCHED; PG8_LDA(At, 0, 0); PG8_STAGE(PG8_SA(1, 1), a1 + hstepA, voffA);
            PG8_WAIT_L(8); PG8_BAR; PG8_WAIT_L(0); PG8_MMA(0, 0, At, B0); PG8_BAR; PG8_SCHED;
            PG8_LDB(B1, 0, 1); PG8_STAGE(PG8_SB(0, 0), b2, voffB);
            PG8_BAR; PG8_WAIT_L(0); PG8_MMA(0, 1, At, B1); PG8_BAR;
            PG8_LDA(At, 0, 1); PG8_STAGE(PG8_SA(0, 0), a2, voffA);
            PG8_BAR; PG8_WAIT_L(0); PG8_MMA(1, 0, At, B0); PG8_BAR; PG8_SCHED;
            PG8_STAGE(PG8_SB(0, 1), b2 + hstepB, voffB);
            PG8_WAIT_V(6); PG8_BAR; PG8_MMA(1, 1, At, B1); PG8_BAR;
            PG8_LDB(B0, 1, 0); PG8_SCHED; PG8_LDA(At, 1, 0); PG8_STAGE(PG8_SA(0, 1), a2 + hstepA, voffA);
            PG8_WAIT_L(8); PG8_BAR; PG8_WAIT_L(0); PG8_MMA(0, 0, At, B0); PG8_BAR; PG8_SCHED;
            PG8_LDB(B1, 1, 1); PG8_STAGE(PG8_SB(1, 0), b3, voffB);
            PG8_BAR; PG8_WAIT_L(0); PG8_MMA(0, 1, At, B1); PG8_BAR;
            PG8_LDA(At, 1, 1); PG8_STAGE(PG8_SA(1, 0), a3, voffA);
            PG8_BAR; PG8_WAIT_L(0); PG8_MMA(1, 0, At, B0); PG8_BAR; PG8_SCHED;
            PG8_STAGE(PG8_SB(1, 1), b3 + hstepB, voffB);
            PG8_WAIT_V(6); PG8_BAR; PG8_MMA(1, 1, At, B1); PG8_BAR;
            }
        }
        if constexpr (ALIGN_EPI) { if (wr == 0) PG8_BAR; }
        if constexpr (!Epi::AFTER_DRAIN) { E(acc, cur, wr, wc, fr, fq); S.done(cur); }
        if (!has_next) break;
#pragma unroll
        for (int a = 0; a < 2; ++a)
#pragma unroll
            for (int b = 0; b < 2; ++b)
#pragma unroll
                for (int m = 0; m < 4; ++m)
#pragma unroll
                    for (int n = 0; n < 2; ++n) acc[a][b][m][n] = (f32x4){0.f, 0.f, 0.f, 0.f};
        cur = nxt; cA = nA; cB = nB; ++ui;
        if constexpr (ALIGN_EPI) { if (wr == 1) PG8_BAR; }
    }
    PG8_WAIT_V(0);
    if constexpr (!ALIGN_EPI) { if (wr == 0) PG8_BAR; }
    PG8_BAR;
    if constexpr (Epi::AFTER_DRAIN) { E.fused(acc, cur, wr, wc, fr, fq, lds, wid, lane); S.done(cur); }
#undef PG8_SA
#undef PG8_SB
#undef PG8_STAGE
#undef PG8_LDA
#undef PG8_LDB
#undef PG8_MMA
#undef PG8_WAIT_V
#undef PG8_WAIT_L
#undef PG8_BAR
#undef PG8_SCHED
}
}

namespace mk {
using pg8::bf16_t;
typedef short bf16x8 __attribute__((ext_vector_type(8)));
typedef short s16x4 __attribute__((ext_vector_type(4)));
typedef float f32x16 __attribute__((ext_vector_type(16)));
typedef float f32x4 __attribute__((ext_vector_type(4)));
typedef unsigned u32x4 __attribute__((ext_vector_type(4)));
#define MK_LAS __attribute__((address_space(3)))
constexpr int T = 98304, TP = 65536, D = 1024, FF = 2816, INW = 2304, SEQ = 4096;
constexpr int LDS_BYTES = 133120;
constexpr float INV0 = 1.000000000e+00f, INV1 = 1.939227447e-01f, INV2 = 3.760603093e-02f, INV3 = 7.292664737e-03f, INV4 = 1.414213562e-03f, INV5 = 2.742481757e-04f, INV6 = 5.318295897e-05f, INV7 = 1.031338538e-05f;
constexpr size_t OFF_BIG = 0;
constexpr size_t OFF_MERGED = (size_t)T * FF * 2;
constexpr size_t OFF_XB = OFF_MERGED + (size_t)T * D * 2;
constexpr size_t OFF_LSE = OFF_XB + (size_t)T * D * 2;
constexpr size_t OFF_W = OFF_LSE + (size_t)3 * T * 8 * 4;
constexpr size_t SZ_GU = (size_t)2 * FF * D * 2, SZ_DN = (size_t)D * FF * 2, SZ_IN = (size_t)INW * D * 2, SZ_OUT = (size_t)D * D * 2;
constexpr size_t OFF_GU1 = OFF_W, OFF_DN1 = OFF_GU1 + SZ_GU, OFF_GU2 = OFF_DN1 + SZ_DN, OFF_DN2 = OFF_GU2 + SZ_GU, OFF_WIN = OFF_DN2 + SZ_DN, OFF_WOUT = OFF_WIN + SZ_IN;
constexpr size_t OFF_SS = OFF_WOUT + SZ_OUT;
constexpr size_t OFF_ROPE = OFF_SS + (size_t)5 * T * 4;
constexpr size_t OFF_BAR = OFF_ROPE + (size_t)SEQ * 16 * 4;
constexpr size_t WS_END = OFF_BAR + 16384;

struct Args { const float* in[17]; float* out; unsigned char* ws; int ph_lo, ph_hi; };

__device__ __forceinline__ unsigned pk2(float lo, float hi) { return pg8::cvt_pk_bf16(lo, hi); }
__device__ __forceinline__ float wave_sum(float v) {
#pragma unroll
    for (int o = 1; o < 64; o <<= 1) v += __shfl_xor(v, o);
    return v;
}
#define MK_LDS_WAIT() asm volatile("s_waitcnt lgkmcnt(0)" ::: "memory")

__device__ __forceinline__ void p0_weight_item(const float* W0, const float* W1, int kind, int K, int Nsrc, const float* gain0, const float* gain1, bf16_t* WT, MK_LAS float* scr, int item, int nblk, int lane) {
    const int kb = item / nblk, nb = item % nblk, k0 = 64 * kb, n0 = 32 * nb;
    const int ng = lane & 7, kg = lane >> 3, R = n0 + 4 * ng;
    const float* src; int col;
    if (kind == 0) { const int n = (R >> 2) & 1; col = 128 * (R >> 8) + 32 * ((R >> 5) & 3) + 8 * ((R >> 3) & 3) + 4 * ((R >> 7) & 1); src = n ? W1 : W0; }
    else if (kind == 2) { const int hd = R >> 6, lc = R & 63; const bool qk = (hd < 10) || (hd >= 12 && hd < 28);
        col = (qk && lc < 16) ? (R & ~15) + ((lc >> 2) & 1) * 8 + ((lc >> 3) & 1) * 4 : R; src = W0; }
    else { col = R; src = W0; }
    f32x4 wv[8]; float gv[8];
#pragma unroll
    for (int i = 0; i < 8; ++i) { const int k = k0 + 8 * i + kg;
        wv[i] = *(const f32x4*)(src + (size_t)k * Nsrc + col);
        gv[i] = gain0 ? ((gain1 && k >= 512) ? gain1[k - 512] : gain0[k]) : 1.0f; }
#pragma unroll
    for (int i = 0; i < 8; ++i) { MK_LAS float* d = scr + (8 * i + kg) * 33 + 4 * ng;
        d[0] = wv[i][0] * gv[i]; d[1] = wv[i][1] * gv[i]; d[2] = wv[i][2] * gv[i]; d[3] = wv[i][3] * gv[i]; }
    MK_LDS_WAIT();
    const int c = lane & 7;
#pragma unroll
    for (int j = 0; j < 4; ++j) { const int n = (lane >> 3) + 8 * j; const MK_LAS float* s = scr + (8 * c) * 33 + n;
        u32x4 o; o.x = pk2(s[0 * 33], s[1 * 33]); o.y = pk2(s[2 * 33], s[3 * 33]); o.z = pk2(s[4 * 33], s[5 * 33]); o.w = pk2(s[6 * 33], s[7 * 33]);
        *(u32x4*)(WT + ((((size_t)((n0 + n) >> 8)) * (K >> 6) + (k0 >> 6)) * 256 + ((n0 + n) & 255)) * 64 + 8 * c) = o; }
    MK_LDS_WAIT();
}

__device__ __forceinline__ void phase_prologue(const Args& a, MK_LAS unsigned char* lds, int gw, int NGW, int wave, int lane) {
    MK_LAS float* scr = (MK_LAS float*)(lds + wave * 8448);
    unsigned char* ws = a.ws;
    constexpr int I_GU = (D / 64) * (2 * FF / 32), I_DN = (FF / 64) * (D / 32), I_IN = (D / 64) * (INW / 32), I_OUT = (D / 64) * (D / 32);
    constexpr int NITEMS = 2 * I_GU + 2 * I_DN + I_IN + I_OUT;
    for (int it = gw; it < NITEMS; it += NGW) {
        int r = it; const float *W0, *W1 = nullptr, *g0 = nullptr, *g1 = nullptr; int kind = 1, K = D, Nsrc = D; size_t woff;
        if (r < 2 * I_GU) { const bool s2 = r >= I_GU; r -= s2 ? I_GU : 0; W0 = a.in[s2 ? 13 : 3]; W1 = a.in[s2 ? 14 : 4]; g0 = a.in[s2 ? 12 : 2]; kind = 0; Nsrc = FF; woff = s2 ? OFF_GU2 : OFF_GU1; }
        else if (r < 2 * I_GU + 2 * I_DN) { r -= 2 * I_GU; const bool s2 = r >= I_DN; r -= s2 ? I_DN : 0; W0 = a.in[s2 ? 15 : 5]; K = FF; woff = s2 ? OFF_DN2 : OFF_DN1; }
        else if (r < 2 * I_GU + 2 * I_DN + I_IN) { r -= 2 * I_GU + 2 * I_DN; W0 = a.in[7]; g0 = a.in[6]; Nsrc = INW; kind = 2; woff = OFF_WIN; }
        else { r -= 2 * I_GU + 2 * I_DN + I_IN; W0 = a.in[11]; g0 = a.in[9]; g1 = a.in[10]; woff = OFF_WOUT; }
        const int nblk = (kind == 0 ? 2 * FF : Nsrc) / 32;
        p0_weight_item(W0, W1, kind, K, Nsrc, g0, g1, (bf16_t*)(ws + woff), scr, r, nblk, lane);
    }
    bf16_t* xb = (bf16_t*)(ws + OFF_XB); float* ss = (float*)(ws + OFF_SS);
    constexpr int RB = 8;
    for (int row0 = gw * RB; row0 < T; row0 += NGW * RB) {
        f32x4 v[RB][4];
#pragma unroll
        for (int q = 0; q < RB; ++q) { const int row = row0 + q; const float* xr = row < TP ? a.in[0] + (size_t)row * D : a.in[1] + (size_t)(row - TP) * D;
#pragma unroll
            for (int j = 0; j < 2; ++j) { v[q][2 * j] = *(const f32x4*)(xr + j * 512 + lane * 8); v[q][2 * j + 1] = *(const f32x4*)(xr + j * 512 + lane * 8 + 4); } }
#pragma unroll
        for (int q = 0; q < RB; ++q) { const int row = row0 + q; float s = 0.f;
#pragma unroll
            for (int j = 0; j < 2; ++j) { const f32x4 v0 = v[q][2 * j], v1 = v[q][2 * j + 1];
                s += (v0[0] * v0[0] + v0[1] * v0[1]) + (v0[2] * v0[2] + v0[3] * v0[3]) + (v1[0] * v1[0] + v1[1] * v1[1]) + (v1[2] * v1[2] + v1[3] * v1[3]);
                u32x4 w; w.x = pk2(v0[0], v0[1]); w.y = pk2(v0[2], v0[3]); w.z = pk2(v1[0], v1[1]); w.w = pk2(v1[2], v1[3]);
                *(u32x4*)(xb + pg8::blk1024(row, j * 512 + lane * 8)) = w; }
            s = wave_sum(s);
            if (lane == 0) { ss[row] = s; ss[T + row] = 0.f; ss[2 * T + row] = 0.f; ss[3 * T + row] = 0.f; } }
    }
    float* rope = (float*)(ws + OFF_ROPE);
    for (int i = gw * 64 + lane; i < SEQ * 8; i += NGW * 64) {
        const int pos = i >> 3, j = i & 7;
        const float inv = j == 0 ? INV0 : j == 1 ? INV1 : j == 2 ? INV2 : j == 3 ? INV3 : j == 4 ? INV4 : j == 5 ? INV5 : j == 6 ? INV6 : INV7;
        const float ang = (float)pos * inv;
        double tr = (double)ang * 0.15915494309189535; tr -= __builtin_floor(tr);
        const float fr = (float)tr;
        rope[pos * 16 + j] = __builtin_amdgcn_cosf(fr); rope[pos * 16 + 8 + j] = __builtin_amdgcn_sinf(fr);
    }
}

__device__ __forceinline__ int crow(int r, int hi) { return (r & 3) + 8 * (r >> 2) + 4 * hi; }
typedef short v4i16_t __attribute__((ext_vector_type(4)));
__device__ __forceinline__ s16x4 vtr(const MK_LAS unsigned char* p) { return __builtin_bit_cast(s16x4, __builtin_amdgcn_ds_read_tr16_b64_v4i16((MK_LAS v4i16_t*)p)); }
#define MK_MFMA32(a, b, c) __builtin_amdgcn_mfma_f32_32x32x16_bf16(a, b, c, 0, 0, 0)
constexpr int ATT_NK = 384, ATT_KCS = (ATT_NK + 2) * 16  , ATT_VOFF = 49408, ATT_VDS = ATT_NK * 64 + 128  , ATT_WOFF = ATT_VOFF + 2 * ATT_VDS, ATT_WSZ = 4224;
static_assert(8 * ATT_KCS <= ATT_VOFF && ATT_WOFF + 8 * ATT_WSZ <= LDS_BYTES, "attention LDS map");
constexpr float ATT_THR = 8.0f;
#define MK_WAIT_BAR() asm volatile("s_waitcnt lgkmcnt(0)\n\ts_barrier" ::: "memory")

struct AttItem {
    size_t rowbase;
    int qcol, kcol, vcol;
    int stride, res, hw, L;
    int kb0, NK;
    int q0;
    int isA;
    bf16_t* out; int out_ld, out_col;
    float* lse;
};
__device__ __forceinline__ void att_decode(const Args& a, int id, AttItem& I) {
    unsigned char* ws = a.ws;
    bf16_t* merged = (bf16_t*)(ws + OFF_MERGED);
    constexpr int NA = 24 * 2 * 64;
    if (id < NA) {
        const int n = id >> 7, kvh = (id >> 6) & 1, qb = id & 63;
        I.rowbase = (size_t)n * SEQ; I.qcol = kvh * 256; I.kcol = 512 + kvh * 64; I.vcol = 640 + kvh * 64;
        I.stride = 1; I.res = 0; I.hw = 128; I.L = SEQ; I.kb0 = 64 * qb - 128; I.NK = 320; I.q0 = 64 * qb; I.isA = 1;
        I.out = merged; I.out_ld = 1024; I.out_col = kvh * 256; I.lse = nullptr;
    } else {
        const int idb = id - NA; const int n = idb / 384, rem = idb - n * 384, h = rem / 48, k = rem - h * 48, g = k >> 4, f = k & 15;
        const int sh = 2 * g, dd = 1 << sh, c = f >> sh;
        I.rowbase = (size_t)n * SEQ; I.qcol = 768 + h * 64; I.kcol = 1280 + h * 64; I.vcol = 1792 + h * 64;
        I.stride = dd; I.res = f & (dd - 1); I.hw = 64; I.L = SEQ >> sh; I.kb0 = 256 * c - 64; I.NK = 384; I.q0 = 256 * c; I.isA = 0;
        if (g == 0) { I.out = merged; I.out_ld = 1024; I.out_col = 512 + h * 64; }
        else { I.out = (bf16_t*)a.out + (size_t)(g - 1) * T * 512; I.out_ld = 512; I.out_col = h * 64; }
        I.lse = (float*)(ws + OFF_LSE) + (size_t)g * T * 8 + h;
    }
}
__device__ __forceinline__ void att_prefetch(const bf16_t* __restrict__ proj, const AttItem& I, int tid, int wave, u32x4 (&kr)[6], u32x4 (&vr)[6], bf16x8 (&qr)[4]) {
    const size_t tokstride = (size_t)I.stride * INW;
    {
        const int lane = tid & 63, r32 = lane & 31, hi = lane >> 5;
        const int hsel = I.isA ? (wave & 3) : 0, t0 = I.q0 + 32 * (I.isA ? (wave >> 2) : wave);
        const bf16_t* qp = proj + (I.rowbase + I.res) * INW + (size_t)(t0 + r32) * tokstride + I.qcol + hsel * 64 + hi * 8;
#pragma unroll
        for (int d0 = 0; d0 < 4; ++d0) qr[d0] = *(const bf16x8*)(qp + d0 * 16);
    }
    const bf16_t* seq0 = proj + (I.rowbase + I.res) * INW + (tid & 7) * 8;
#pragma unroll
    for (int i = 0; i < 6; ++i) {
        const int row = i * 64 + (tid >> 3), key = I.kb0 + row;
        if (row < I.NK && key >= 0 && key < I.L) { const bf16_t* p = seq0 + (size_t)key * tokstride; kr[i] = *(const u32x4*)(p + I.kcol); vr[i] = *(const u32x4*)(p + I.vcol); }
        else { kr[i] = (u32x4){0u, 0u, 0u, 0u}; vr[i] = (u32x4){0u, 0u, 0u, 0u}; }
    }
}
__device__ __forceinline__ void att_store(MK_LAS unsigned char* lds, int tid, const u32x4 (&kr)[6], const u32x4 (&vr)[6]) {
    const int chunk = tid & 7;
    MK_LAS unsigned char* kp = lds + chunk * ATT_KCS + (tid >> 3) * 16;
    MK_LAS unsigned char* vp = lds + ATT_VOFF + (chunk >> 2) * ATT_VDS + (tid >> 3) * 64 + (chunk & 3) * 16;
#pragma unroll
    for (int i = 0; i < 6; ++i) { *(MK_LAS u32x4*)(kp + i * 64 * 16) = kr[i]; *(MK_LAS u32x4*)(vp + i * 64 * 64) = vr[i]; }
}

struct AttPend { bf16_t* p; size_t step; float* lsep; float lsev; int valid; };
__device__ __forceinline__ void att_flush(const AttPend& P, MK_LAS unsigned char* lds, int wave, int lane) {
    if (!P.valid) return;
    const MK_LAS bf16_t* stg = (const MK_LAS bf16_t*)(lds + ATT_WOFF + wave * ATT_WSZ);
#pragma unroll
    for (int i = 0; i < 4; ++i) { const int row = i * 8 + (lane >> 3), ch = lane & 7; *(u32x4*)(P.p + i * P.step) = *(const MK_LAS u32x4*)(stg + row * 64 + ch * 8); }
    if (P.lsep) *P.lsep = P.lsev;
}
__device__ __forceinline__ void att_compute(const AttItem& I, MK_LAS unsigned char* lds, int wave, int lane, const bf16x8 (&qr)[4], const float sink_l2, const bool do_store, AttPend& P) {
    const int r32 = lane & 31, hi = lane >> 5;
    MK_LAS unsigned char* wl = lds + ATT_WOFF + wave * ATT_WSZ;
    MK_LAS float* wsf = (MK_LAS float*)(wl + 4096);
    const int hsel = I.isA ? (wave & 3) : 0;
    const int t0 = I.q0 + 32 * (I.isA ? (wave >> 2) : wave);
    const int ocol = I.out_col + hsel * 64;
    const int nkt = I.hw / 16 + 1;
    const int kt_lo = t0 >= I.hw ? 0 : ((I.hw - t0) >> 5);
    int kt_hi = (I.L - t0 + I.hw) >> 5; kt_hi = kt_hi < nkt ? kt_hi : nkt;
    const MK_LAS unsigned char* kfb = lds + hi * ATT_KCS + r32 * 16;
    const MK_LAS unsigned char* vfb = lds + ATT_VOFF + ((lane >> 4) & 1) * 32 + (lane & 3) * 8 + (4 * hi + ((lane & 15) >> 2)) * 64;
    float mhat = -1.0e4f, lsum = 0.f;
    f32x16 o0 = {}, o1 = {};
    for (int kt = kt_lo; kt < kt_hi; ++kt) {
        const int krow0 = t0 - I.hw + 32 * kt - I.kb0;
        const MK_LAS unsigned char* kp = kfb + krow0 * 16;
        bf16x8 kf[4];
#pragma unroll
        for (int d0 = 0; d0 < 4; ++d0) kf[d0] = *(const MK_LAS bf16x8*)(kp + 2 * d0 * ATT_KCS);
        const MK_LAS unsigned char* vp = vfb + krow0 * 64;
#define MK_VFR(off) __builtin_shufflevector(vtr(vp + (off)), vtr(vp + (off) + 512), 0, 1, 2, 3, 4, 5, 6, 7)
        const bf16x8 v00 = MK_VFR(0), v01 = MK_VFR(ATT_VDS), v10 = MK_VFR(1024), v11 = MK_VFR(ATT_VDS + 1024);
#undef MK_VFR
        f32x16 p = {};
#pragma unroll
        for (int d0 = 0; d0 < 4; ++d0) p = MK_MFMA32(kf[d0], qr[d0], p);
        if (kt == 0) {
#pragma unroll
            for (int r = 0; r < 16; ++r) if (crow(r, hi) < r32) p[r] = -1.0e30f;
        }
        if (kt == nkt - 1) {
#pragma unroll
            for (int r = 0; r < 16; ++r) if (crow(r, hi) > r32) p[r] = -1.0e30f;
        }
        float rm = __builtin_fmaxf(p[0], p[1]);
#pragma unroll
        for (int r = 2; r < 16; ++r) rm = __builtin_fmaxf(rm, p[r]);
        rm = __builtin_fmaxf(rm, __shfl_xor(rm, 32));
        if (__any(rm > mhat + ATT_THR)) {
            const float mnew = __builtin_fmaxf(mhat, rm), f = __builtin_amdgcn_exp2f(mhat - mnew);
            lsum *= f; mhat = mnew;
            if (hi == 0) wsf[r32] = f;
            MK_LDS_WAIT();
#pragma unroll
            for (int g = 0; g < 4; ++g) { const f32x4 w4 = *(const MK_LAS f32x4*)(wsf + 8 * g + 4 * hi);
#pragma unroll
                for (int j = 0; j < 4; ++j) { o0[4 * g + j] *= w4[j]; o1[4 * g + j] *= w4[j]; } }
            MK_LDS_WAIT();
        }
        float sacc = 0.f;
#pragma unroll
        for (int r = 0; r < 16; ++r) { p[r] = __builtin_amdgcn_exp2f(p[r] - mhat); sacc += p[r]; }
        lsum += sacc;
        u32x4 pw0, pw1;
        pw0.x = pk2(p[0], p[1]); pw0.y = pk2(p[2], p[3]); pw0.z = pk2(p[4], p[5]); pw0.w = pk2(p[6], p[7]);
        pw1.x = pk2(p[8], p[9]); pw1.y = pk2(p[10], p[11]); pw1.z = pk2(p[12], p[13]); pw1.w = pk2(p[14], p[15]);
        o0 = MK_MFMA32(__builtin_bit_cast(bf16x8, pw0), v00, o0); o1 = MK_MFMA32(__builtin_bit_cast(bf16x8, pw0), v01, o1);
        o0 = MK_MFMA32(__builtin_bit_cast(bf16x8, pw1), v10, o0); o1 = MK_MFMA32(__builtin_bit_cast(bf16x8, pw1), v11, o1);
    }
    float ltot = lsum + __shfl_xor(lsum, 32);
    if (I.isA) ltot += __builtin_amdgcn_exp2f(sink_l2 - mhat);
    const float rl = 1.0f / ltot;
    if (hi == 0) wsf[r32] = rl;
    MK_LDS_WAIT();
    MK_LAS bf16_t* stg = (MK_LAS bf16_t*)wl;
#pragma unroll
    for (int g = 0; g < 4; ++g) { const f32x4 w4 = *(const MK_LAS f32x4*)(wsf + 8 * g + 4 * hi);
#pragma unroll
        for (int j = 0; j < 4; ++j) { const int r = 4 * g + j, orow = crow(r, hi);
            stg[orow * 64 + r32] = (bf16_t)(pk2(o0[r] * w4[j], 0.f) & 0xffffu); stg[orow * 64 + 32 + r32] = (bf16_t)(pk2(o1[r] * w4[j], 0.f) & 0xffffu); } }
    MK_LDS_WAIT();
    P.valid = do_store ? 1 : 0;
    P.p = I.out + (I.rowbase + I.res + (size_t)I.stride * (t0 + (lane >> 3))) * I.out_ld + ocol + (lane & 7) * 8;
    P.step = (size_t)8 * I.stride * I.out_ld;
    P.lsep = (I.lse && hi == 0) ? I.lse + (I.rowbase + I.res + (size_t)I.stride * (t0 + r32)) * 8 : nullptr;
    P.lsev = mhat + __builtin_log2f(ltot);
}

__device__ __forceinline__ void phase_attention(const Args& a, MK_LAS unsigned char* lds, int vcu, int G, int tid, int wave, int lane, const int mode) {
    const bf16_t* proj = (const bf16_t*)(a.ws + OFF_BIG);
    constexpr int NITEMS = 24 * 2 * 64 + 24 * 8 * 48;
    u32x4 kr[6], vr[6]; bf16x8 qn[4];
    int id = vcu;
    AttItem I;
#pragma unroll
    for (int i = 0; i < 6; ++i) { kr[i] = (u32x4){0u, 0u, 0u, 0u}; vr[i] = kr[i]; }
#pragma unroll
    for (int i = 0; i < 4; ++i) qn[i] = (bf16x8){0, 0, 0, 0, 0, 0, 0, 0};
    AttPend P; P.valid = 0; P.p = nullptr; P.step = 0; P.lsep = nullptr; P.lsev = 0.f;
    const float sinkA = a.in[8][wave & 3] * 1.4426950408889634f, sinkB = a.in[8][4 + (wave & 3)] * 1.4426950408889634f;
    if (id < NITEMS) { att_decode(a, id, I); if (mode != 1) att_prefetch(proj, I, tid, wave, kr, vr, qn); }
    while (id < NITEMS) {
        if (mode != 1) att_store(lds, tid, kr, vr);
        att_flush(P, lds, wave, lane);
        bf16x8 qr[4];
#pragma unroll
        for (int d0 = 0; d0 < 4; ++d0) qr[d0] = qn[d0];
        MK_WAIT_BAR();
        const int nid = id + G;
        if (nid < NITEMS && mode != 1) { AttItem N; att_decode(a, nid, N); att_prefetch(proj, N, tid, wave, kr, vr, qn); }
        if (mode != 2) att_compute(I, lds, wave, lane, qr, (I.qcol >> 8) ? sinkB : sinkA, mode == 0, P);
        MK_WAIT_BAR();
        id = nid;
        if (id < NITEMS) att_decode(a, id, I);
    }
    att_flush(P, lds, wave, lane);
}

__device__ __forceinline__ void unpack8(const u32x4 w, float (&v)[8]) {
    v[0] = __uint_as_float(w.x << 16); v[1] = __uint_as_float(w.x & 0xffff0000u); v[2] = __uint_as_float(w.y << 16); v[3] = __uint_as_float(w.y & 0xffff0000u);
    v[4] = __uint_as_float(w.z << 16); v[5] = __uint_as_float(w.z & 0xffff0000u); v[6] = __uint_as_float(w.w << 16); v[7] = __uint_as_float(w.w & 0xffff0000u);
}
__device__ __forceinline__ u32x4 pack8(const float (&v)[8], float s) { u32x4 w; w.x = pk2(v[0] * s, v[1] * s); w.y = pk2(v[2] * s, v[3] * s); w.z = pk2(v[4] * s, v[5] * s); w.w = pk2(v[6] * s, v[7] * s); return w; }
__device__ __forceinline__ void phase_finalize(const Args& a, int gw, int NGW, int lane) {
    unsigned char* ws = a.ws;
    bf16_t* merged = (bf16_t*)(ws + OFF_MERGED); const bf16_t* ob2 = (const bf16_t*)a.out; const bf16_t* ob3 = ob2 + (size_t)T * 512; const float* lse = (const float*)(ws + OFF_LSE);
    const int h = lane >> 3;
    constexpr int RB = 4;
    for (int row0 = gw * RB; row0 < T; row0 += NGW * RB) {
        u32x4 wa[RB], w1[RB], w2[RB], w3[RB]; float l1[RB], l2[RB], l3[RB];
#pragma unroll
        for (int q = 0; q < RB; ++q) { const size_t row = row0 + q; const bf16_t* mr = merged + row * 1024;
            wa[q] = *(const u32x4*)(mr + lane * 8); w1[q] = *(const u32x4*)(mr + 512 + lane * 8);
            w2[q] = *(const u32x4*)(ob2 + row * 512 + lane * 8); w3[q] = *(const u32x4*)(ob3 + row * 512 + lane * 8);
            l1[q] = lse[row * 8 + h]; l2[q] = lse[(size_t)T * 8 + row * 8 + h]; l3[q] = lse[(size_t)2 * T * 8 + row * 8 + h]; }
#pragma unroll
        for (int q = 0; q < RB; ++q) { bf16_t* mr = merged + (size_t)(row0 + q) * 1024;
            float va[8], b1[8], b2[8], b3[8];
            unpack8(wa[q], va); unpack8(w1[q], b1); unpack8(w2[q], b2); unpack8(w3[q], b3);
            const float mx = __builtin_fmaxf(l1[q], __builtin_fmaxf(l2[q], l3[q]));
            const float e1 = __builtin_amdgcn_exp2f(l1[q] - mx), e2 = __builtin_amdgcn_exp2f(l2[q] - mx), e3 = __builtin_amdgcn_exp2f(l3[q] - mx), ri = 1.0f / (e1 + e2 + e3);
            const float c1 = e1 * ri, c2 = e2 * ri, c3 = e3 * ri;
            float sa = 0.f, sb = 0.f;
#pragma unroll
            for (int j = 0; j < 8; ++j) { b1[j] = c1 * b1[j] + c2 * b2[j] + c3 * b3[j]; sa += va[j] * va[j]; sb += b1[j] * b1[j]; }
            sa = wave_sum(sa); sb = wave_sum(sb);
            const float ra = __builtin_amdgcn_rsqf(sa * (1.0f / 512.0f) + 1e-6f), rb = __builtin_amdgcn_rsqf(sb * (1.0f / 512.0f) + 1e-6f);
            *(u32x4*)(mr + lane * 8) = pack8(va, ra);
            *(u32x4*)(mr + 512 + lane * 8) = pack8(b1, rb); }
    }
}

__device__ __forceinline__ void phase_final_norm(const Args& a, int gw, int NGW, int lane) {
    const float* ss = (const float*)(a.ws + OFF_SS) + (size_t)3 * T; const float* gain = a.in[16]; const bf16_t* xb = (const bf16_t*)(a.ws + OFF_XB);
    f32x4 g[4];
#pragma unroll
    for (int j = 0; j < 2; ++j) { g[2 * j] = *(const f32x4*)(gain + j * 512 + lane * 8); g[2 * j + 1] = *(const f32x4*)(gain + j * 512 + lane * 8 + 4); }
    constexpr int RB = 8;
    for (int row0 = gw * RB; row0 < T; row0 += NGW * RB) {
        u32x4 v[RB][2]; float rs[RB];
#pragma unroll
        for (int q = 0; q < RB; ++q) { rs[q] = ss[row0 + q];
#pragma unroll
            for (int j = 0; j < 2; ++j) v[q][j] = *(const u32x4*)(xb + pg8::blk1024(row0 + q, j * 512 + lane * 8)); }
#pragma unroll
        for (int q = 0; q < RB; ++q) { float* xr = a.out + (size_t)(row0 + q) * D; const float r = pg8::rstd_of(rs[q]);
#pragma unroll
            for (int j = 0; j < 2; ++j) { float f[8]; unpack8(v[q][j], f);
                const f32x4 o0 = (f32x4){f[0], f[1], f[2], f[3]} * r * g[2 * j], o1 = (f32x4){f[4], f[5], f[6], f[7]} * r * g[2 * j + 1];
                *(f32x4*)(xr + j * 512 + lane * 8) = o0; *(f32x4*)(xr + j * 512 + lane * 8 + 4) = o1; } }
    }
}


#define XB_TMO      128
#define XB_XCNT(j)  (256  + 64 * (j))
#define XB_XSUB(j)  (1280 + 64 * (j))
#define XB_XGEN(j)  (2304 + 64 * (j))
#define XB_TOP      3328
#define XB_TOPGEN   3392
#define XCD_BAR_WORDS 3456
#define XB_SPIN_CAP (1u << 18)
__device__ __forceinline__ unsigned xb_ld(unsigned* p)              { return __hip_atomic_load(p, __ATOMIC_RELAXED, __HIP_MEMORY_SCOPE_AGENT); }
__device__ __forceinline__ unsigned xb_add(unsigned* p, unsigned v) { return __hip_atomic_fetch_add(p, v, __ATOMIC_RELAXED, __HIP_MEMORY_SCOPE_AGENT); }
__device__ __forceinline__ unsigned xb_xcc_id() { return (unsigned)__builtin_amdgcn_s_getreg((3 << 11) | 20) & 0xFu; }
#define XB_SPIN(cond, bar) do { unsigned _sp = 0; while (cond) { __builtin_amdgcn_s_sleep(1); \
    if ((++_sp & 255u) == 0u) { if (xb_ld(&(bar)[XB_TMO])) break; if (_sp > XB_SPIN_CAP) { atomicAdd(&(bar)[XB_TMO], 1u); break; } } } } while (0)
struct XcdBarrier { unsigned* bar; unsigned x; volatile MK_LAS unsigned* st; };
__device__ __forceinline__ void xcd_barrier_complete(unsigned* bar, unsigned x, unsigned& nloc, unsigned& nx) {
    const unsigned G = gridDim.x * gridDim.y * gridDim.z;
    unsigned sum, cnt, mine, sp = 0u;
    for (;;) {
        sum = 0u; cnt = 0u; mine = 0u;
#pragma unroll
        for (unsigned j = 0; j < 16; ++j) { const unsigned c = xb_ld(&bar[XB_XCNT(j)]); sum += c; cnt += (c > 0u) ? 1u : 0u; mine = (j == x) ? c : mine; }
        if (sum == G) break;
        __builtin_amdgcn_s_sleep(1);
        if ((++sp & 255u) == 0u) { if (xb_ld(&bar[XB_TMO])) break; if (sp > XB_SPIN_CAP) { atomicAdd(&bar[XB_TMO], 1u); break; } }
    }
    nloc = mine > 0u ? mine : 1u; nx = cnt > 0u ? cnt : 1u;
}
__device__ __forceinline__ void xcd_barrier(const XcdBarrier& b) {
    asm volatile("s_waitcnt vmcnt(0)" ::: "memory");
    __syncthreads();
    if (threadIdx.x == 0) {
        unsigned* bar = b.bar;
        __builtin_amdgcn_s_waitcnt(0);
        unsigned nloc = b.st[0], nx = b.st[1];
        if (nloc == 0u) { xcd_barrier_complete(bar, b.x, nloc, nx); b.st[0] = nloc; b.st[1] = nx; }
        const unsigned old = xb_add(&bar[XB_XSUB(b.x)], 1u);
        const unsigned gen = old / nloc;
        if (old + 1u == (gen + 1u) * nloc) {
            __builtin_amdgcn_fence(__ATOMIC_RELEASE, "agent");
            asm volatile("s_waitcnt vmcnt(0)" ::: "memory");
            const unsigned og = xb_add(&bar[XB_TOP], 1u);
            const unsigned tg = og / nx;
            if (og + 1u == (tg + 1u) * nx) xb_add(&bar[XB_TOPGEN], 1u);
            else XB_SPIN(xb_ld(&bar[XB_TOPGEN]) == tg, bar);
            __builtin_amdgcn_fence(__ATOMIC_ACQUIRE, "agent");
            xb_add(&bar[XB_XGEN(b.x)], 1u);
            asm volatile("s_waitcnt vmcnt(0)" ::: "memory");
        } else {
            XB_SPIN(xb_ld(&bar[XB_XGEN(b.x)]) == gen, bar);
            __builtin_amdgcn_fence(__ATOMIC_ACQUIRE, "agent");
            asm volatile("s_waitcnt vmcnt(0)" ::: "memory");
        }
    }
    __syncthreads();
}

constexpr int NPHASE = 10;
#ifndef MK_STAG_GU
#define MK_STAG_GU 0
#endif
__device__ __forceinline__ void mk_stagger(int bid, int ticks) {
    const int g = (bid >> 3) & 7;
    if (ticks > 0 && g) { const unsigned long long t0 = __builtin_amdgcn_s_memrealtime(), w = (unsigned long long)(g * ticks);
        while (__builtin_amdgcn_s_memrealtime() - t0 < w) __builtin_amdgcn_s_sleep(4); }
}
#ifndef MK_MASK
#define MK_MASK 0x3ff
#endif
#define MK_ON(p) ((MK_MASK >> (p)) & 1)
__global__ __launch_bounds__(512) void mk_fwd(const Args a) {
    extern __shared__ __attribute__((aligned(16))) unsigned char lds_raw[];
    MK_LAS unsigned char* lds = (MK_LAS unsigned char*)lds_raw;
    cg::grid_group grid = cg::this_grid();
    volatile MK_LAS unsigned* xst = (volatile MK_LAS unsigned*)(lds + LDS_BYTES - 16);
    if (threadIdx.x == 0) { xst[0] = 0u; xst[1] = 0u; (void)xb_add(&((unsigned*)(a.ws + OFF_BAR))[XB_XCNT(xb_xcc_id())], 1u); }
    __syncthreads();
#ifndef MK_REP
#define MK_REP 0
#endif
#ifndef MK_GU_PROBE
#define MK_GU_PROBE 1
#endif
#ifndef MK_ATT_PROBE
#define MK_ATT_PROBE 0
#endif
    for (int ph2 = a.ph_lo * 2; ph2 < a.ph_hi * 2; ++ph2) {
        const int ph = ph2 >> 1;
        if ((ph2 & 1) && !((MK_REP >> ph) & 1)) continue;
        if (ph2 > a.ph_lo * 2) {
            if (a.ph_hi > NPHASE) grid.sync();
            else { XcdBarrier xb; xb.bar = (unsigned*)(a.ws + OFF_BAR); xb.x = xb_xcc_id(); xb.st = xst; xcd_barrier(xb); }
        }
        int tid = threadIdx.x; asm volatile("" : "+v"(tid));
        const int lane = tid & 63, wave = __builtin_amdgcn_readfirstlane(tid >> 6);
        int G = gridDim.x, bid = blockIdx.x; asm volatile("" : "+s"(G), "+s"(bid));
        const int vcu = (bid & 7) * (G >> 3) + (bid >> 3);
        const int gw = vcu * 8 + wave, NGW = G * 8;
        size_t wzero = 0; asm volatile("" : "+s"(wzero)); unsigned char* ws = a.ws + wzero;
        float* ss = (float*)(ws + OFF_SS);
        if (MK_ON(0) && ph == 0) phase_prologue(a, lds, gw, NGW, wave, lane);
        else if (MK_ON(1) && (ph == 1 || ph == 7)) {
            const bool second = ph == 7;
            mk_stagger(bid, MK_STAG_GU);
            pg8::Gemm g; g.A = (const bf16_t*)(ws + OFF_XB); g.Bt = (const bf16_t*)(ws + (second ? OFF_GU2 : OFF_GU1)); g.M = T; g.N = 2 * FF; g.K = D; g.a_blocked = 1;
            pg8::StaticOrder S; S.init(T, 2 * FF, G, bid);
            pg8::EpiGateUp E; E.H = (bf16_t*)(ws + OFF_BIG); E.ss = ss + (second ? 2 * (size_t)T : 0); E.enabled = (ph2 & 1) ? MK_GU_PROBE : 1;
            pg8::gemm_phase<pg8::EpiGateUp, pg8::StaticOrder, true, true>(lds, g, S, E, tid);
        } else if (MK_ON(2) && (ph == 2 || ph == 6 || ph == 8)) {
            pg8::Gemm g; pg8::EpiResid E; E.split = TP; E.res_lo = a.in[0]; E.res_hi = a.in[1]; E.xb = (bf16_t*)(ws + OFF_XB);
            if (ph == 2) { g.A = (const bf16_t*)(ws + OFF_BIG); g.Bt = (const bf16_t*)(ws + OFF_DN1); g.K = FF; E.out = nullptr; E.res_bf16 = 0; E.write_xb = 1; E.ssout = ss + T; E.alpha = 0.5f; }
            else if (ph == 6) { g.A = (const bf16_t*)(ws + OFF_MERGED); g.Bt = (const bf16_t*)(ws + OFF_WOUT); g.K = D; E.out = nullptr; E.res_bf16 = 1; E.write_xb = 1; E.ssout = ss + 2 * (size_t)T; E.alpha = 1.0f; }
            else { g.A = (const bf16_t*)(ws + OFF_BIG); g.Bt = (const bf16_t*)(ws + OFF_DN2); g.K = FF; E.out = nullptr; E.res_bf16 = 1; E.write_xb = 1; E.ssout = ss + 3 * (size_t)T; E.alpha = 0.5f; }
            g.M = T; g.N = D; g.a_blocked = (ph == 6) ? 0 : 1;
            pg8::StaticOrder S; S.init(T, D, G, bid);
            pg8::gemm_phase<pg8::EpiResid, pg8::StaticOrder, true, true>(lds, g, S, E, tid);
        } else if (MK_ON(3) && ph == 3) {
            pg8::Gemm g; g.A = (const bf16_t*)(ws + OFF_XB); g.Bt = (const bf16_t*)(ws + OFF_WIN); g.M = T; g.N = INW; g.K = D; g.a_blocked = 1;
            pg8::StaticOrder S; S.init(T, INW, G, bid);
            pg8::EpiQkv E; E.P = (bf16_t*)(ws + OFF_BIG); E.ss = ss + T; E.rope = (const float*)(ws + OFF_ROPE);
            pg8::gemm_phase<pg8::EpiQkv, pg8::StaticOrder, true, true>(lds, g, S, E, tid);
        } else if (MK_ON(4) && ph == 4) phase_attention(a, lds, vcu, G, tid, wave, lane, (ph2 & 1) ? MK_ATT_PROBE : 0);
        else if (MK_ON(5) && ph == 5) phase_finalize(a, gw, NGW, lane);
        else if (MK_ON(9) && ph == 9) phase_final_norm(a, gw, NGW, lane);
    }
}
}

#ifndef MK_N_LAUNCHES
#define MK_N_LAUNCHES 1
#endif
extern "C" void kernel_launch(void* const* d_in, const int* in_sizes, int n_in, void* d_out, int out_size, void* d_ws, size_t ws_size, hipStream_t stream) {
    static int grid = 0;
    if (grid == 0) {
        if (n_in != 17 || out_size != mk::T * mk::D || ws_size < mk::WS_END) { fprintf(stderr, "kernel_launch: unexpected shapes (n_in %d out %d ws %zu need %zu)\n", n_in, out_size, ws_size, (size_t)mk::WS_END); grid = -1; return; }
        int dev = 0, cus = 0, per_cu = 0;
        hipGetDevice(&dev); hipDeviceGetAttribute(&cus, hipDeviceAttributeMultiprocessorCount, dev);
        if (hipFuncSetAttribute((const void*)mk::mk_fwd, hipFuncAttributeMaxDynamicSharedMemorySize, mk::LDS_BYTES) != hipSuccess) { fprintf(stderr, "kernel_launch: hipFuncSetAttribute failed\n"); grid = -1; return; }
        if (hipOccupancyMaxActiveBlocksPerMultiprocessor(&per_cu, (const void*)mk::mk_fwd, 512, mk::LDS_BYTES) != hipSuccess || per_cu < 1) { fprintf(stderr, "kernel_launch: occupancy query says %d\n", per_cu); per_cu = 1; }
        (void)hipGetLastError();
        grid = cus * 1;
        if (grid % 8) grid -= grid % 8;
    }
    if (grid < 0) return;
    if (hipMemsetAsync((char*)d_ws + mk::OFF_BAR, 0, 16384, stream) != hipSuccess) { fprintf(stderr, "kernel_launch: memset of the barrier words failed\n"); return; }
    mk::Args a{};
    for (int i = 0; i < 17; ++i) a.in[i] = (const float*)d_in[i];
    a.out = (float*)d_out; a.ws = (unsigned char*)d_ws;
#if MK_N_LAUNCHES == 1
    a.ph_lo = 0; a.ph_hi = 10;
    void* args[] = {(void*)&a};
    hipError_t e = hipLaunchCooperativeKernel((const void*)mk::mk_fwd, dim3(grid), dim3(512), args, mk::LDS_BYTES, stream);
    if (e != hipSuccess) fprintf(stderr, "kernel_launch: cooperative launch failed: %s (grid %d)\n", hipGetErrorString(e), grid);
#else
    for (int p = 0; p < 10; ++p) { a.ph_lo = p; a.ph_hi = p + 1; hipLaunchKernelGGL(mk::mk_fwd, dim3(grid), dim3(512), mk::LDS_BYTES, stream, a); }
#endif
}
```
